# Optimizing an MI355X kernel written in HIP

```python
import math
import jax
import jax.numpy as jnp
from jax import lax
import numpy as np

D_MODEL = 1024
BATCH = 32
SEQ = 2048
DEPTH = 2

MIX_WIDTH = D_MODEL
GROUP_WIDTH = MIX_WIDTH // 4
SSD_HEAD_DIM = 64
SSD_HEADS = GROUP_WIDTH // SSD_HEAD_DIM
SSD_N_GROUPS = 2
SSD_STATE = 128
SSD_CONV = 4
SSD_CHUNK = 128
SSD_XBC = GROUP_WIDTH + 2 * SSD_N_GROUPS * SSD_STATE
RET_HEAD_DIM = 64
RET_HEADS = GROUP_WIDTH // RET_HEAD_DIM
RET_CHUNK = 128
ROPE_BASE = 10000.0
LRU_BLOCKS = 4
LRU_BLOCK_DIM = GROUP_WIDTH // LRU_BLOCKS
LRU_CONV = 4
LRU_C = 8.0
GLA_HEADS = 4
GLA_VAL_DIM = GROUP_WIDTH // GLA_HEADS
GLA_KEY_DIM = GLA_VAL_DIM // 2
GLA_GATE_RANK = 16
GLA_GATE_NORM = 16.0
GLA_CHUNK = 64
D_FF = -(-8 * D_MODEL // (3 * 256)) * 256
DEEPNORM_ALPHA = (2 * DEPTH) ** 0.25
DEEPNORM_BETA = (8 * DEPTH) ** -0.25
EPS = 1e-5
IN_SPLITS = (GROUP_WIDTH, SSD_XBC, SSD_HEADS,
             GROUP_WIDTH, GROUP_WIDTH, GROUP_WIDTH, GROUP_WIDTH,
             GROUP_WIDTH, GROUP_WIDTH,
             GLA_HEADS * GLA_KEY_DIM, GLA_HEADS * GLA_KEY_DIM,
             GROUP_WIDTH, GLA_GATE_RANK, GROUP_WIDTH)
IN_WIDTH = sum(IN_SPLITS)

kernel_name = 'hybrid_ssd_retnet_rglru_gla_deepnorm_adaln'


def layer_norm(x, w, b):
    xf = x.astype(jnp.float32)
    mu = jnp.mean(xf, axis=-1, keepdims=True)
    var = jnp.mean(jnp.square(xf - mu), axis=-1, keepdims=True)
    return ((xf - mu) * lax.rsqrt(var + EPS) * w + b).astype(x.dtype)


def rms_norm(x, w):
    xf = x.astype(jnp.float32)
    return (xf * lax.rsqrt(jnp.mean(jnp.square(xf), axis=-1, keepdims=True) + EPS) * w).astype(x.dtype)


def head_group_norm(y, w):
    yf = y.astype(jnp.float32)
    mu = jnp.mean(yf, axis=-1, keepdims=True)
    var = jnp.mean(jnp.square(yf - mu), axis=-1, keepdims=True)
    return ((yf - mu) * lax.rsqrt(var + EPS) * w).astype(y.dtype)


def causal_depthwise_conv(x, w, b):
    width, ch = w.shape
    y = lax.conv_general_dilated(x, w[:, None, :], window_strides=(1,), padding=[(width - 1, 0)],
                                 dimension_numbers=('NWC', 'WIO', 'NWC'), feature_group_count=ch)
    return y + b


def apply_rotary(x, positions):
    half = x.shape[-1] // 2
    inv_freq = ROPE_BASE ** (-jnp.arange(half, dtype=jnp.float32) / half)
    ang = positions.astype(jnp.float32)[..., None] * inv_freq
    cos = jnp.cos(ang)[:, :, None, :]
    sin = jnp.sin(ang)[:, :, None, :]
    x1, x2 = x[..., :half], x[..., half:]
    return jnp.concatenate([x1 * cos - x2 * sin, x2 * cos + x1 * sin], axis=-1).astype(x.dtype)


def scan_chunk_states(states, chunk_decay):
    def step(h, inp):
        st, dec = inp
        return h * dec + st, h
    h0 = jnp.zeros_like(states[:, 0])
    _, prev = lax.scan(step, h0, (jnp.moveaxis(states, 1, 0), jnp.moveaxis(chunk_decay, 1, 0)))
    return jnp.moveaxis(prev, 0, 1)


def chunked_scalar_decay(q, k, v, log_a, chunk):
    bsz, seq, nh, n = q.shape
    p = v.shape[-1]
    nc = seq // chunk
    q = q.reshape(bsz, nc, chunk, nh, n)
    k = k.reshape(bsz, nc, chunk, nh, n)
    v = v.reshape(bsz, nc, chunk, nh, p)
    cum = jnp.cumsum(log_a.astype(jnp.float32).reshape(bsz, nc, chunk, nh), axis=2)
    causal = jnp.tril(jnp.ones((chunk, chunk), dtype=bool))
    seg = cum[:, :, :, None, :] - cum[:, :, None, :, :]
    decay = jnp.exp(jnp.where(causal[:, :, None], seg, -jnp.inf))
    scores = jnp.einsum('bcthn,bcshn->bctsh', q, k) * decay
    y_intra = jnp.einsum('bctsh,bcshp->bcthp', scores, v)
    to_end = jnp.exp(cum[:, :, -1:, :] - cum)
    states = jnp.einsum('bcsh,bcshn,bcshp->bchnp', to_end, k, v).astype(jnp.float32)
    chunk_decay = jnp.exp(cum[:, :, -1, :])[..., None, None]
    prev = scan_chunk_states(states, chunk_decay)
    y_inter = jnp.einsum('bcth,bcthn,bchnp->bcthp', jnp.exp(cum), q, prev)
    return (y_intra + y_inter).reshape(bsz, seq, nh, p).astype(v.dtype)


def chunked_gla(q, k, v, log_a, chunk):
    bsz, seq, nh, kd = q.shape
    vd = v.shape[-1]
    nc = seq // chunk
    q = q.reshape(bsz, nc, chunk, nh, kd)
    k = k.reshape(bsz, nc, chunk, nh, kd)
    v = v.reshape(bsz, nc, chunk, nh, vd)
    cum = jnp.cumsum(log_a.astype(jnp.float32).reshape(bsz, nc, chunk, nh, kd), axis=2)
    q_in = q * jnp.exp(cum)
    k_in = k * jnp.exp(-cum)
    k_end = k * jnp.exp(cum[:, :, -1:] - cum)
    causal = jnp.tril(jnp.ones((chunk, chunk), dtype=bool))
    scores = jnp.where(causal, jnp.einsum('bcthk,bcshk->bchts', q_in, k_in), 0.0)
    y_intra = jnp.einsum('bchts,bcshv->bcthv', scores, v)
    states = jnp.einsum('bcshk,bcshv->bchkv', k_end, v).astype(jnp.float32)
    chunk_decay = jnp.exp(cum[:, :, -1])[..., None]
    prev = scan_chunk_states(states, chunk_decay)
    y_inter = jnp.einsum('bcthk,bchkv->bcthv', q_in, prev)
    return (y_intra + y_inter).reshape(bsz, seq, nh, vd).astype(v.dtype)


def linear_recurrence(a, u):
    def combine(left, right):
        a_l, u_l = left
        a_r, u_r = right
        return a_l * a_r, a_r * u_l + u_r
    _, h = lax.associative_scan(combine, (a, u), axis=1)
    return h


def ssd_group(z, xbc, dt_raw, conv_w, conv_b, dt_bias, a_log, d_skip, norm_w):
    bsz, seq, _ = z.shape
    xbc = jax.nn.silu(causal_depthwise_conv(xbc, conv_w, conv_b))
    xs, b_in, c_in = jnp.split(xbc, [GROUP_WIDTH, GROUP_WIDTH + SSD_N_GROUPS * SSD_STATE], axis=-1)
    xs = xs.reshape(bsz, seq, SSD_HEADS, SSD_HEAD_DIM)
    rep = SSD_HEADS // SSD_N_GROUPS
    b_in = jnp.repeat(b_in.reshape(bsz, seq, SSD_N_GROUPS, SSD_STATE), rep, axis=2)
    c_in = jnp.repeat(c_in.reshape(bsz, seq, SSD_N_GROUPS, SSD_STATE), rep, axis=2)
    dt = jax.nn.softplus((dt_raw + dt_bias).astype(jnp.float32))
    log_a = -jnp.exp(a_log.astype(jnp.float32)) * dt
    y = chunked_scalar_decay(c_in, b_in, xs * dt[..., None], log_a, SSD_CHUNK)
    y = (y + xs * d_skip[:, None]).reshape(bsz, seq, GROUP_WIDTH)
    return rms_norm(y * jax.nn.silu(z), norm_w)


def retention_group(q, k, v, g, positions, norm_w):
    bsz, seq, _ = q.shape
    shp = (bsz, seq, RET_HEADS, RET_HEAD_DIM)
    q = apply_rotary(q.reshape(shp), positions)
    k = apply_rotary(k.reshape(shp), positions) * (RET_HEAD_DIM ** -0.5)
    log_gamma = jnp.log1p(-jnp.exp2(-5.0 - jnp.arange(RET_HEADS, dtype=jnp.float32)))
    log_a = jnp.broadcast_to(log_gamma, (bsz, seq, RET_HEADS))
    y = chunked_scalar_decay(q, k, v.reshape(shp), log_a, RET_CHUNK)
    y = head_group_norm(y, norm_w.reshape(RET_HEADS, RET_HEAD_DIM)).reshape(bsz, seq, GROUP_WIDTH)
    return y * jax.nn.silu(g)


def rglru_group(gate, xr, conv_w, conv_b, wa, ba, wx, bx, lam):
    bsz, seq, _ = xr.shape
    xr = causal_depthwise_conv(xr, conv_w, conv_b)
    xb = xr.reshape(bsz, seq, LRU_BLOCKS, LRU_BLOCK_DIM)
    r = jax.nn.sigmoid(jnp.einsum('bski,kij->bskj', xb, wa).reshape(bsz, seq, GROUP_WIDTH) + ba)
    i = jax.nn.sigmoid(jnp.einsum('bski,kij->bskj', xb, wx).reshape(bsz, seq, GROUP_WIDTH) + bx)
    log_a = -LRU_C * r.astype(jnp.float32) * jax.nn.softplus(-lam.astype(jnp.float32))
    a = jnp.exp(log_a)
    u = jnp.sqrt(-jnp.expm1(2.0 * log_a)) * (i * xr).astype(jnp.float32)
    h = linear_recurrence(a, u).astype(xr.dtype)
    return h * jax.nn.gelu(gate)


def gla_group(q, k, v, g_low, r, wg2, bg, norm_w):
    bsz, seq, _ = q.shape
    q = q.reshape(bsz, seq, GLA_HEADS, GLA_KEY_DIM) * (GLA_KEY_DIM ** -0.5)
    k = k.reshape(bsz, seq, GLA_HEADS, GLA_KEY_DIM)
    v = v.reshape(bsz, seq, GLA_HEADS, GLA_VAL_DIM)
    log_a = jax.nn.log_sigmoid((g_low @ wg2 + bg).astype(jnp.float32)) / GLA_GATE_NORM
    log_a = log_a.reshape(bsz, seq, GLA_HEADS, GLA_KEY_DIM)
    o = chunked_gla(q, k, v, log_a, GLA_CHUNK)
    o = rms_norm(o, norm_w.reshape(GLA_HEADS, GLA_VAL_DIM)).reshape(bsz, seq, GROUP_WIDTH)
    return o * jax.nn.silu(r)


def hybrid_mixer(h, positions, w_in, ssd_conv_w, ssd_conv_b, ssd_dt_bias, ssd_a_log, ssd_d, ssd_norm_w,
                 ret_norm_w, lru_conv_w, lru_conv_b, lru_wa, lru_ba, lru_wx, lru_bx, lru_lambda,
                 gla_wg2, gla_bg, gla_norm_w, w_out):
    proj = jnp.einsum('bsd,de->bse', h, w_in)
    split_at = np.cumsum(IN_SPLITS)[:-1].tolist()
    (ssd_z, ssd_xbc, ssd_dt, ret_q, ret_k, ret_v, ret_g, lru_gate, lru_x,
     gla_q, gla_k, gla_v, gla_glow, gla_r) = jnp.split(proj, split_at, axis=-1)
    y_ssd = ssd_group(ssd_z, ssd_xbc, ssd_dt, ssd_conv_w, ssd_conv_b, ssd_dt_bias, ssd_a_log, ssd_d, ssd_norm_w)
    y_ret = retention_group(ret_q, ret_k, ret_v, ret_g, positions, ret_norm_w)
    y_lru = rglru_group(lru_gate, lru_x, lru_conv_w, lru_conv_b, lru_wa, lru_ba, lru_wx, lru_bx, lru_lambda)
    y_gla = gla_group(gla_q, gla_k, gla_v, gla_glow, gla_r, gla_wg2, gla_bg, gla_norm_w)
    y = jnp.concatenate([y_ssd, y_ret, y_lru, y_gla], axis=-1)
    return jnp.einsum('bse,ed->bsd', y, w_out)


def swiglu(h, w_up, w_down):
    g, u = jnp.split(jnp.einsum('bsd,df->bsf', h, w_up), 2, axis=-1)
    return jnp.einsum('bsf,fd->bsd', jax.nn.silu(g) * u, w_down)


def setup_inputs(seed: int = 0) -> dict:
    key = jax.random.key(seed)
    ks = iter(jax.random.split(key, 40))
    f32 = jnp.float32
    L, D = DEPTH, D_MODEL

    def nrm(shape, scale):
        return jax.random.normal(next(ks), shape, f32) * scale

    x = nrm((BATCH, SEQ, D), 1.0)
    c = nrm((BATCH, D), 1.0)
    offsets = jax.random.randint(next(ks), (BATCH, 1), 0, 4096, dtype=jnp.int32)
    positions = (offsets + jnp.arange(SEQ, dtype=jnp.int32)[None, :]).astype(jnp.int32)
    w_ada = nrm((L, D, 6 * D), D ** -0.5)
    b_ada = nrm((L, 6 * D), 0.02)
    w_in = nrm((L, D, IN_WIDTH), D ** -0.5)
    ssd_conv_w = nrm((L, SSD_CONV, SSD_XBC), SSD_CONV ** -0.5)
    ssd_conv_b = nrm((L, SSD_XBC), 0.02)
    dt0 = jnp.exp(jax.random.uniform(next(ks), (L, SSD_HEADS), f32, math.log(1e-3), math.log(1e-1)))
    ssd_dt_bias = dt0 + jnp.log(-jnp.expm1(-dt0))
    ssd_a_log = jnp.log(jax.random.uniform(next(ks), (L, SSD_HEADS), f32, 1.0, 16.0))
    ssd_d = 1.0 + nrm((L, SSD_HEADS), 0.02)
    ssd_norm_w = 1.0 + nrm((L, GROUP_WIDTH), 0.02)
    ret_norm_w = 1.0 + nrm((L, GROUP_WIDTH), 0.02)
    lru_conv_w = nrm((L, LRU_CONV, GROUP_WIDTH), LRU_CONV ** -0.5)
    lru_conv_b = nrm((L, GROUP_WIDTH), 0.02)
    lru_wa = nrm((L, LRU_BLOCKS, LRU_BLOCK_DIM, LRU_BLOCK_DIM), LRU_BLOCK_DIM ** -0.5)
    lru_ba = nrm((L, GROUP_WIDTH), 0.02)
    lru_wx = nrm((L, LRU_BLOCKS, LRU_BLOCK_DIM, LRU_BLOCK_DIM), LRU_BLOCK_DIM ** -0.5)
    lru_bx = nrm((L, GROUP_WIDTH), 0.02)
    a0 = jax.random.uniform(next(ks), (L, GROUP_WIDTH), f32, 0.9, 0.999)
    s0 = a0 ** (1.0 / LRU_C)
    lru_lambda = jnp.log(s0) - jnp.log1p(-s0)
    gla_wg2 = nrm((L, GLA_GATE_RANK, GLA_HEADS * GLA_KEY_DIM), GLA_GATE_RANK ** -0.5)
    gla_bg = nrm((L, GLA_HEADS * GLA_KEY_DIM), 0.02)
    gla_norm_w = 1.0 + nrm((L, GROUP_WIDTH), 0.02)
    w_out = nrm((L, MIX_WIDTH, D), MIX_WIDTH ** -0.5 * DEEPNORM_BETA)
    ln1_w = 1.0 + nrm((L, D), 0.02)
    ln1_b = nrm((L, D), 0.02)
    ffn_w_up = nrm((L, D, 2 * D_FF), D ** -0.5)
    ffn_w_down = nrm((L, D_FF, D), D_FF ** -0.5 * DEEPNORM_BETA)
    ln2_w = 1.0 + nrm((L, D), 0.02)
    ln2_b = nrm((L, D), 0.02)
    return {'x': x, 'c': c, 'positions': positions, 'w_ada': w_ada, 'b_ada': b_ada, 'w_in': w_in,
            'ssd_conv_w': ssd_conv_w, 'ssd_conv_b': ssd_conv_b, 'ssd_dt_bias': ssd_dt_bias,
            'ssd_a_log': ssd_a_log, 'ssd_d': ssd_d, 'ssd_norm_w': ssd_norm_w, 'ret_norm_w': ret_norm_w,
            'lru_conv_w': lru_conv_w, 'lru_conv_b': lru_conv_b, 'lru_wa': lru_wa, 'lru_ba': lru_ba,
            'lru_wx': lru_wx, 'lru_bx': lru_bx, 'lru_lambda': lru_lambda, 'gla_wg2': gla_wg2,
            'gla_bg': gla_bg, 'gla_norm_w': gla_norm_w, 'w_out': w_out, 'ln1_w': ln1_w, 'ln1_b': ln1_b,
            'ffn_w_up': ffn_w_up, 'ffn_w_down': ffn_w_down, 'ln2_w': ln2_w, 'ln2_b': ln2_b}


def reference(x, c, positions, w_ada, b_ada, w_in, ssd_conv_w, ssd_conv_b, ssd_dt_bias, ssd_a_log, ssd_d,
              ssd_norm_w, ret_norm_w, lru_conv_w, lru_conv_b, lru_wa, lru_ba, lru_wx, lru_bx, lru_lambda,
              gla_wg2, gla_bg, gla_norm_w, w_out, ln1_w, ln1_b, ffn_w_up, ffn_w_down, ln2_w, ln2_b):
    c_act = jax.nn.silu(c)
    for l in range(DEPTH):
        mod = c_act @ w_ada[l] + b_ada[l]
        sh_m, sc_m, g_m, sh_f, sc_f, g_f = [m[:, None, :] for m in jnp.split(mod, 6, axis=-1)]
        h = x * (1.0 + sc_m) + sh_m
        y = hybrid_mixer(h, positions, w_in[l], ssd_conv_w[l], ssd_conv_b[l], ssd_dt_bias[l], ssd_a_log[l],
                         ssd_d[l], ssd_norm_w[l], ret_norm_w[l], lru_conv_w[l], lru_conv_b[l], lru_wa[l],
                         lru_ba[l], lru_wx[l], lru_bx[l], lru_lambda[l], gla_wg2[l], gla_bg[l],
                         gla_norm_w[l], w_out[l])
        x = layer_norm(DEEPNORM_ALPHA * x + g_m * y, ln1_w[l], ln1_b[l])
        h = x * (1.0 + sc_f) + sh_f
        y = swiglu(h, ffn_w_up[l], ffn_w_down[l])
        x = layer_norm(DEEPNORM_ALPHA * x + g_f * y, ln2_w[l], ln2_b[l])
    return x
```

```cpp
#include <hip/hip_runtime.h>
#include <hip/hip_cooperative_groups.h>
#include <cstdio>
namespace cg = cooperative_groups;

#define LAS __attribute__((address_space(3)))
typedef unsigned short bf16_t;
typedef short bf16x8 __attribute__((ext_vector_type(8)));
typedef float f32x4 __attribute__((ext_vector_type(4)));
typedef unsigned u32x4 __attribute__((ext_vector_type(4)));
typedef unsigned u32x2 __attribute__((ext_vector_type(2)));

constexpr int T = 65536, D = 1024, SEQ = 2048, NB = 32;
constexpr int INW = 3348, INP = 3584, DFF = 2816, NUP = 5632;
constexpr float ALPHA = 1.4142135623730951f;
constexpr float EPS = 1e-5f;
constexpr int C_SSD_Z = 0, C_SSD_XBC = 256, C_SSD_DT = 1024, C_RET_Q = 1028, C_RET_K = 1284, C_RET_V = 1540, C_RET_G = 1796,
              C_LRU_G = 2052, C_LRU_X = 2308, C_GLA_Q = 2564, C_GLA_K = 2692, C_GLA_V = 2820, C_GLA_GL = 3076, C_GLA_R = 3092;
constexpr size_t SZ_WIN = (size_t)INP * D * 2, SZ_WOUT = (size_t)D * D * 2, SZ_WUP = (size_t)NUP * D * 2, SZ_WDN = (size_t)D * DFF * 2;
constexpr size_t WS_WIN = 0, WS_WOUT = WS_WIN + 2 * SZ_WIN, WS_WUP = WS_WOUT + 2 * SZ_WOUT, WS_WDN = WS_WUP + 2 * SZ_WUP,
                 WS_MOD = WS_WDN + 2 * SZ_WDN, WS_H = WS_MOD + (size_t)2 * NB * 6144 * 4, WS_X = WS_H + (size_t)T * D * 2,
                 WS_P = WS_X + (size_t)T * D * 4, WS_END = WS_P + (size_t)T * INP * 2;
constexpr size_t WS_BAR = WS_END, WS_STATS = WS_END + 16384, WS_TOTAL = WS_STATS + (size_t)T * 8;
constexpr int LDS_BYTES = 135168;
constexpr int LDS_XB = 131072;

__device__ __forceinline__ float bf2f(bf16_t v) { return __uint_as_float(((unsigned)v) << 16); }
__device__ __forceinline__ unsigned pk2(float lo, float hi) { unsigned r; asm volatile("v_cvt_pk_bf16_f32 %0, %1, %2" : "=v"(r) : "v"(lo), "v"(hi)); return r; }
__device__ __forceinline__ bf16_t f2bf(float f) { return (bf16_t)(pk2(f, 0.f) & 0xffffu); }
__device__ __forceinline__ float sigmoidf_(float x) { return __builtin_amdgcn_rcpf(1.f + __expf(-x)); }
__device__ __forceinline__ float siluf_(float x) { return x * sigmoidf_(x); }
__device__ __forceinline__ float softplusf_(float x) { return x > 20.f ? x : log1pf(expf(x)); }
__device__ __forceinline__ int lane_id() { unsigned z = 0u; asm volatile("" : "+s"(z)); return (int)__builtin_amdgcn_mbcnt_hi(~0u, __builtin_amdgcn_mbcnt_lo(~0u, z)); }
#define dpp_f(v, ctrl) __builtin_bit_cast(float, __builtin_amdgcn_update_dpp(0, __builtin_bit_cast(int, (v)), (ctrl), 0xF, 0xF, true))
__device__ __forceinline__ float wave_sum(float v) {
    v += dpp_f(v, 0xB1); v += dpp_f(v, 0x4E); v += dpp_f(v, 0x141); v += dpp_f(v, 0x140);
    const int vi = __builtin_bit_cast(int, v);
    const float s0 = __builtin_bit_cast(float, __builtin_amdgcn_readlane(vi, 0)), s1 = __builtin_bit_cast(float, __builtin_amdgcn_readlane(vi, 16)),
                s2 = __builtin_bit_cast(float, __builtin_amdgcn_readlane(vi, 32)), s3 = __builtin_bit_cast(float, __builtin_amdgcn_readlane(vi, 48));
    return (s0 + s1) + (s2 + s3);
}

typedef const unsigned long long __attribute__((address_space(4)))* karg_t;
__device__ __forceinline__ karg_t kargs() { karg_t p = (karg_t)__builtin_amdgcn_kernarg_segment_ptr(); asm volatile("" : "+s"(p)); return p; }
__device__ __forceinline__ const float* argf(int i) { return (const float*)kargs()[i]; }
__device__ __forceinline__ unsigned char* argws() { return (unsigned char*)kargs()[31]; }
__device__ __forceinline__ float* argout() { return (float*)kargs()[30]; }
__device__ __forceinline__ int lv(int v) { asm volatile("" : "+v"(v)); return v; }
__device__ __forceinline__ int ls(int v) { asm volatile("" : "+s"(v)); return v; }

namespace pg8 {
constexpr int BM = 256, BK = 64, HALF = 128, HTB = HALF * BK * 2, STAGE_BYTES = 8 * HTB, NXCD = 8, WGM = 4;
__device__ __forceinline__ int lds_byte(int r, int c) { const int st = (r >> 4) * 2 + (c >> 5), rr = r & 15, cc = c & 31, ob = rr * 64 + cc * 2; return st * 1024 + (ob ^ (((ob >> 9) & 1) << 5)); }
__device__ __forceinline__ void stage_rc(int b, int& R, int& C) { const int st = b / 1024, sb = b % 1024, swz = sb ^ (((sb >> 9) & 1) << 5); R = (st >> 1) * 16 + swz / 64; C = (st & 1) * 32 + (swz % 64) / 2; }
__device__ __forceinline__ int perm32(int rho) { const int n = rho >> 4, i = rho & 15; return 8 * (i >> 2) + 4 * n + (i & 3); }
struct Unit { int pm, pn; };
struct Gemm { const bf16_t* A; const bf16_t* Bt; int M, N, K; };
struct StaticOrder {
    int nM, nN, nwg, G, c, wgm;
    __device__ void init(int M, int N, int G_, int c_, int wgm_ = WGM) { nM = M / BM; nN = N / BM; nwg = nM * nN; G = G_; c = c_; wgm = wgm_; }
    __device__ bool next(int i, Unit& u) const {
        const long L = (long)i * G + c; if (L >= nwg) return false;
        int wgid = (int)L; { const int q = nwg / NXCD, r = nwg % NXCD, xcd = wgid % NXCD, off = wgid / NXCD; wgid = (xcd < r ? xcd * (q + 1) : r * (q + 1) + (xcd - r) * q) + off; }
        const int nig = wgm * nN, gid = wgid / nig, fm = gid * wgm, gsz = (nM - fm) < wgm ? (nM - fm) : wgm;
        u.pm = fm + ((wgid % nig) % gsz); u.pn = (wgid % nig) / gsz; return true;
    }
};
struct EpiP {
    static constexpr bool PERM = true;
    bf16_t* O; int ldc;
    __device__ __forceinline__ void operator()(const f32x4 (&acc)[2][2][4][2], const Unit& u, int wr, int wc, int fr, int fq) const {
        const int row0 = u.pm * BM + wr * 64 + fr, col0 = u.pn * BM + wc * 32 + 8 * fq;
        asm volatile("s_nop 15\n\ts_nop 15" ::: "memory");
#pragma unroll
        for (int ai = 0; ai < 2; ++ai)
#pragma unroll
            for (int m = 0; m < 4; ++m) { bf16_t* rowp = O + (size_t)(row0 + ai * HALF + m * 16) * ldc + col0;
#pragma unroll
                for (int bj = 0; bj < 2; ++bj) { const f32x4 v0 = acc[ai][bj][m][0], v1 = acc[ai][bj][m][1];
                    u32x4 w; w.x = pk2(v0[0], v0[1]); w.y = pk2(v0[2], v0[3]); w.z = pk2(v1[0], v1[1]); w.w = pk2(v1[2], v1[3]);
                    *(u32x4*)(rowp + bj * HALF) = w; } }
    }
};
struct EpiRes {
    static constexpr bool PERM = false;
    const float* Xin; float* Xout; const float* gate;
    const float* stats; const float* lw; const float* lb;
    __device__ __forceinline__ void operator()(const f32x4 (&acc)[2][2][4][2], const Unit& u, int wr, int wc, int fr, int fq) const {
        typedef float f32x2_t __attribute__((ext_vector_type(2)));
        const int row0 = u.pm * BM + wr * 64 + fr, col0 = u.pn * BM + wc * 32 + 4 * fq;
        const float* gp = gate + (size_t)((u.pm * BM) >> 11) * 6144 + col0;
        f32x2_t st[2][4];
#pragma unroll
        for (int ai = 0; ai < 2; ++ai)
#pragma unroll
            for (int m = 0; m < 4; ++m) st[ai][m] = stats ? *(const f32x2_t*)(stats + 2 * (row0 + ai * HALF + m * 16)) : (f32x2_t){0.f, 1.f};
#pragma unroll
        for (int bj = 0; bj < 2; ++bj)
#pragma unroll
            for (int n = 0; n < 2; ++n) { const int co = bj * HALF + n * 16;
                const f32x4 gv = *(const f32x4*)(gp + co);
                f32x4 wv = {1.f, 1.f, 1.f, 1.f}, bv = {0.f, 0.f, 0.f, 0.f};
                if (stats) { wv = *(const f32x4*)(lw + col0 + co); bv = *(const f32x4*)(lb + col0 + co); }
                f32x4 xs[2][4];
#pragma unroll
                for (int ai = 0; ai < 2; ++ai)
#pragma unroll
                    for (int m = 0; m < 4; ++m) xs[ai][m] = *(const f32x4*)(Xin + (size_t)(row0 + ai * HALF + m * 16) * D + col0 + co);
#pragma unroll
                for (int ai = 0; ai < 2; ++ai)
#pragma unroll
                    for (int m = 0; m < 4; ++m) { const size_t ro = (size_t)(row0 + ai * HALF + m * 16) * D + col0 + co;
                        f32x4 x = xs[ai][m];
                        if (stats) x = (x - st[ai][m].x) * st[ai][m].y * wv + bv;
                        *(f32x4*)(Xout + ro) = x * ALPHA + gv * acc[ai][bj][m][n]; } }
    }
};
struct EpiSwiglu {
    static constexpr bool PERM = true;
    bf16_t* G;
    __device__ __forceinline__ void operator()(const f32x4 (&acc)[2][2][4][2], const Unit& u, int wr, int wc, int fr, int fq) const {
        const int row0 = u.pm * BM + wr * 64 + fr, col0 = u.pn * HALF + wc * 32 + 8 * fq;
#pragma unroll
        for (int ai = 0; ai < 2; ++ai)
#pragma unroll
            for (int m = 0; m < 4; ++m) { bf16_t* rowp = G + (size_t)(row0 + ai * HALF + m * 16) * DFF + col0;
                f32x4 o[2];
#pragma unroll
                for (int n = 0; n < 2; ++n)
#pragma unroll
                    for (int j = 0; j < 4; ++j) { const float g = acc[ai][0][m][n][j]; o[n][j] = siluf_(g) * acc[ai][1][m][n][j]; }
                u32x4 w; w.x = pk2(o[0][0], o[0][1]); w.y = pk2(o[0][2], o[0][3]); w.z = pk2(o[1][0], o[1][1]); w.w = pk2(o[1][2], o[1][3]);
                *(u32x4*)rowp = w; }
    }
};

template <class Epi, bool ALIGN_EPI = true, bool SP2 = true>
__device__ __forceinline__ void gemm_phase(LAS unsigned char* lds, const Gemm g, const StaticOrder& S, const Epi& E, const int wave_s) {
    int lane_ = lane_id(); asm volatile("" : "+v"(lane_));
    const int wid = wave_s, lane = lane_, tid = wid * 64 + lane, wr = wid >> 2, wc = wid & 3, fr = lane & 15, fq = lane >> 4;
    const int K = g.K, nt = K / BK;
    unsigned voffA[2], voffB[2];
#pragma unroll
    for (int i = 0; i < 2; ++i) { int R, C; stage_rc(tid * 16 + i * 8192, R, C); const int Rb = Epi::PERM ? ((R & ~31) + perm32(R & 31)) : R;
        voffA[i] = (unsigned)(R * K + C) * 2u; voffB[i] = (unsigned)(Rb * K + C) * 2u; }
    const size_t kstep = (size_t)(BK * 2);
    const size_t hstep = (size_t)HALF * K * 2;
    const size_t tstep = 2 * hstep;
    const unsigned ldsw = (unsigned)wid * 1024u;
    const int aoff = lds_byte(wr * 64 + fr, fq * 8), boff = lds_byte(wc * 32 + fr, fq * 8);
#define PG8_SA(b, h) (((b) * 2 + (h)) * HTB)
#define PG8_SB(b, h) ((4 + (b) * 2 + (h)) * HTB)
#define PG8_STAGE(bufoff, gbase, voff) do { _Pragma("unroll") for (int _i = 0; _i < 2; ++_i) \
        __builtin_amdgcn_global_load_lds((const unsigned*)((const char*)(gbase) + (voff)[_i]), (LAS unsigned*)(lds + (bufoff) + ldsw + _i * 8192), 16, 0, 0); } while (0)
#define PG8_LDA(dst, b, h) do { _Pragma("unroll") for (int m = 0; m < 4; ++m) _Pragma("unroll") for (int k = 0; k < 2; ++k) dst[m][k] = *(const LAS bf16x8*)(lds + PG8_SA(b, h) + aoff + m * 2048 + k * 1024); } while (0)
#define PG8_LDB(dst, b, h) do { _Pragma("unroll") for (int n = 0; n < 2; ++n) _Pragma("unroll") for (int k = 0; k < 2; ++k) dst[n][k] = *(const LAS bf16x8*)(lds + PG8_SB(b, h) + boff + n * 2048 + k * 1024); } while (0)
#define PG8_MMA(ai, bj, At, Bt) do { __builtin_amdgcn_s_setprio(1); _Pragma("unroll") for (int m = 0; m < 4; ++m) _Pragma("unroll") for (int n = 0; n < 2; ++n) _Pragma("unroll") for (int k = 0; k < 2; ++k) \
        acc[ai][bj][m][n] = __builtin_amdgcn_mfma_f32_16x16x32_bf16(Bt[n][k], At[m][k], acc[ai][bj][m][n], 0, 0, 0); __builtin_amdgcn_s_setprio(0); } while (0)
#define PG8_WAIT_V(n) asm volatile("s_waitcnt vmcnt(" #n ")" ::: "memory")
#define PG8_WAIT_L(n) asm volatile("s_waitcnt lgkmcnt(" #n ")" ::: "memory")
#define PG8_BAR __builtin_amdgcn_s_barrier()
#define PG8_SCHED __builtin_amdgcn_sched_barrier(0)
    Unit cur, nxt; int ui = 0;
    if (!S.next(0, cur)) return;
    f32x4 acc[2][2][4][2];
#pragma unroll
    for (int a = 0; a < 2; ++a)
#pragma unroll
        for (int b = 0; b < 2; ++b)
#pragma unroll
            for (int m = 0; m < 4; ++m)
#pragma unroll
                for (int n = 0; n < 2; ++n) acc[a][b][m][n] = (f32x4){0.f, 0.f, 0.f, 0.f};
    bf16x8 At[4][2], B0[2][2], B1[2][2];
    const char* cA = (const char*)g.A + (size_t)cur.pm * tstep; const char* cB = (const char*)g.Bt + (size_t)cur.pn * tstep;
    if constexpr (SP2) {
        PG8_STAGE(PG8_SB(0, 0), cB, voffB); PG8_STAGE(PG8_SB(0, 1), cB + hstep, voffB); PG8_STAGE(PG8_SA(0, 0), cA, voffA); PG8_STAGE(PG8_SA(0, 1), cA + hstep, voffA);
        if (wr == 1) PG8_BAR;
        PG8_WAIT_V(2); PG8_BAR;
        PG8_STAGE(PG8_SB(1, 0), cB + kstep, voffB); PG8_STAGE(PG8_SA(1, 0), cA + kstep, voffA); PG8_STAGE(PG8_SB(1, 1), cB + hstep + kstep, voffB);
        PG8_WAIT_V(6); PG8_BAR;
    } else {
    PG8_STAGE(PG8_SB(0, 0), cB, voffB); PG8_STAGE(PG8_SA(0, 0), cA, voffA); PG8_STAGE(PG8_SB(0, 1), cB + hstep, voffB); PG8_STAGE(PG8_SA(0, 1), cA + hstep, voffA);
    if (wr == 1) PG8_BAR;
    PG8_WAIT_V(4); PG8_BAR;
    PG8_STAGE(PG8_SB(1, 0), cB + kstep, voffB); PG8_STAGE(PG8_SA(1, 0), cA + kstep, voffA); PG8_STAGE(PG8_SB(1, 1), cB + hstep + kstep, voffB);
    PG8_WAIT_V(6); PG8_BAR;
    }
    for (;;) {
        const bool has_next = S.next(ui + 1, nxt);
        const char* nA = has_next ? (const char*)g.A + (size_t)nxt.pm * tstep : cA; const char* nB = has_next ? (const char*)g.Bt + (size_t)nxt.pn * tstep : cB;
        for (int t = 0; t < nt; t += 2) {
            const bool last = (t == nt - 2);
            const char* a1 = cA + (size_t)(t + 1) * kstep;
            const char* a2 = last ? nA : cA + (size_t)(t + 2) * kstep; const char* b2 = last ? nB : cB + (size_t)(t + 2) * kstep;
            const char* a3 = a2 + kstep; const char* b3 = b2 + kstep;
            if constexpr (SP2) {
            PG8_LDB(B0, 0, 0); PG8_LDB(B1, 0, 1); PG8_SCHED; PG8_LDA(At, 0, 0); PG8_STAGE(PG8_SA(1, 1), a1 + hstep, voffA);
            PG8_WAIT_V(8); PG8_WAIT_L(0); PG8_BAR; PG8_MMA(0, 0, At, B0); PG8_MMA(0, 1, At, B1); PG8_BAR; PG8_SCHED;
            PG8_LDA(At, 0, 1); PG8_STAGE(PG8_SB(0, 0), b2, voffB); PG8_STAGE(PG8_SB(0, 1), b2 + hstep, voffB); PG8_STAGE(PG8_SA(0, 0), a2, voffA);
            PG8_WAIT_V(8); PG8_WAIT_L(0); PG8_BAR; PG8_MMA(1, 0, At, B0); PG8_MMA(1, 1, At, B1); PG8_BAR; PG8_SCHED;
            PG8_LDB(B0, 1, 0); PG8_LDB(B1, 1, 1); PG8_SCHED; PG8_LDA(At, 1, 0); PG8_STAGE(PG8_SA(0, 1), a2 + hstep, voffA);
            PG8_WAIT_V(8); PG8_WAIT_L(0); PG8_BAR; PG8_MMA(0, 0, At, B0); PG8_MMA(0, 1, At, B1); PG8_BAR; PG8_SCHED;
            PG8_LDA(At, 1, 1); PG8_STAGE(PG8_SB(1, 0), b3, voffB); PG8_STAGE(PG8_SB(1, 1), b3 + hstep, voffB); PG8_STAGE(PG8_SA(1, 0), a3, voffA);
            PG8_WAIT_V(8); PG8_WAIT_L(0); PG8_BAR; PG8_MMA(1, 0, At, B0); PG8_MMA(1, 1, At, B1); PG8_BAR; PG8_SCHED;
            } else {
            PG8_LDB(B0, 0, 0); PG8_SCHED; PG8_LDA(At, 0, 0); PG8_STAGE(PG8_SA(1, 1), a1 + hstep, voffA);
            PG8_WAIT_L(8); PG8_BAR; PG8_WAIT_L(0); PG8_MMA(0, 0, At, B0); PG8_BAR; PG8_SCHED;
            PG8_LDB(B1, 0, 1); PG8_STAGE(PG8_SB(0, 0), b2, voffB);
            PG8_BAR; PG8_WAIT_L(0); PG8_MMA(0, 1, At, B1); PG8_BAR;
            PG8_LDA(At, 0, 1); PG8_STAGE(PG8_SA(0, 0), a2, voffA);
            PG8_BAR; PG8_WAIT_L(0); PG8_MMA(1, 0, At, B0); PG8_BAR; PG8_SCHED;
            PG8_STAGE(PG8_SB(0, 1), b2 + hstep, voffB);
            PG8_WAIT_V(6); PG8_BAR; PG8_MMA(1, 1, At, B1); PG8_BAR;
            PG8_LDB(B0, 1, 0); PG8_SCHED; PG8_LDA(At, 1, 0); PG8_STAGE(PG8_SA(0, 1), a2 + hstep, voffA);
            PG8_WAIT_L(8); PG8_BAR; PG8_WAIT_L(0); PG8_MMA(0, 0, At, B0); PG8_BAR; PG8_SCHED;
            PG8_LDB(B1, 1, 1); PG8_STAGE(PG8_SB(1, 0), b3, voffB);
            PG8_BAR; PG8_WAIT_L(0); PG8_MMA(0, 1, At, B1); PG8_BAR;
            PG8_LDA(At, 1, 1); PG8_STAGE(PG8_SA(1, 0), a3, voffA);
            PG8_BAR; PG8_WAIT_L(0); PG8_MMA(1, 0, At, B0); PG8_BAR; PG8_SCHED;
            PG8_STAGE(PG8_SB(1, 1), b3 + hstep, voffB);
            PG8_WAIT_V(6); PG8_BAR; PG8_MMA(1, 1, At, B1); PG8_BAR;
            }
        }
        if constexpr (ALIGN_EPI) { if (wr == 0) PG8_BAR; }
        E(acc, cur, wr, wc, fr, fq);
        if (!has_next) break;
#pragma unroll
        for (int a = 0; a < 2; ++a)
#pragma unroll
            for (int b = 0; b < 2; ++b)
#pragma unroll
                for (int m = 0; m < 4; ++m)
#pragma unroll
                    for (int n = 0; n < 2; ++n) acc[a][b][m][n] = (f32x4){0.f, 0.f, 0.f, 0.f};
        cur = nxt; cA = nA; cB = nB; ++ui;
        if constexpr (ALIGN_EPI) { if (wr == 1) PG8_BAR; }
    }
    PG8_WAIT_V(0);
    if constexpr (!ALIGN_EPI) { if (wr == 0) PG8_BAR; }
    PG8_BAR;
#undef PG8_SA
#undef PG8_SB
#undef PG8_STAGE
#undef PG8_LDA
#undef PG8_LDB
#undef PG8_MMA
#undef PG8_WAIT_V
#undef PG8_WAIT_L
#undef PG8_BAR
#undef PG8_SCHED
}
}

__device__ __forceinline__ int colmap(int mode, int n) {
    if (mode == 0) return n < INW ? n : -1;
    if (mode == 2) return ((n >> 7) & 1) * DFF + (n >> 8) * 128 + (n & 127);
    return n;
}
__device__ __forceinline__ void transpose_tile(const float* src, int Nsrc, bf16_t* dst, int K, int n0, int k0, int mode, LAS float* scr, int tid) {
    const int c = tid & 63, r0 = tid >> 6;
    const int sc = colmap(mode, n0 + c);
#pragma unroll
    for (int i = 0; i < 8; ++i) { const int r = r0 + 8 * i; scr[r * 65 + c] = sc >= 0 ? src[(size_t)(k0 + r) * Nsrc + sc] : 0.f; }
    __syncthreads();
    const int kp = (tid & 31) * 2;
#pragma unroll
    for (int i = 0; i < 4; ++i) { const int r = (tid >> 5) + 16 * i;
        *(unsigned*)(dst + (size_t)(n0 + r) * K + k0 + kp) = pk2(scr[kp * 65 + r], scr[(kp + 1) * 65 + r]); }
    __syncthreads();
}
__device__ __forceinline__ void ada_unit(const float* c, const float* w_ada, const float* b_ada, float* mod, int unit, LAS float* lds, int tid_in) {
    const int tid = lv(tid_in);
    const int l = unit / 96, cb = unit % 96;
    for (int i = tid; i < NB * D; i += 512) { const int b = i >> 10, k = i & 1023; lds[k * 32 + b] = siluf_(c[i]); }
    __syncthreads();
    const int col = tid & 63, kg = tid >> 6;
    float acc[32];
#pragma unroll
    for (int b = 0; b < 32; ++b) acc[b] = 0.f;
    { const __amdgpu_buffer_rsrc_t rw = __builtin_amdgcn_make_buffer_rsrc((void*)w_ada, 0, 0x7fffffff, 0x00020000);
      const int kgs = __builtin_amdgcn_readfirstlane(kg), vo = (cb * 64 + col) * 4;
      for (int k0 = kgs * 128; k0 < kgs * 128 + 128; k0 += 8) {
        float w[8];
#pragma unroll
        for (int u = 0; u < 8; ++u) w[u] = __builtin_bit_cast(float, __builtin_amdgcn_raw_buffer_load_b32(rw, vo, ((l * D + k0 + u) * 6144) * 4, 0));
#pragma unroll
        for (int u = 0; u < 8; ++u) {
#pragma unroll
            for (int b4 = 0; b4 < 8; ++b4) { const f32x4 cv = *(const LAS f32x4*)(lds + (k0 + u) * 32 + b4 * 4);
#pragma unroll
                for (int j = 0; j < 4; ++j) acc[b4 * 4 + j] += cv[j] * w[u]; } }
      } }
    __syncthreads();
#pragma unroll
    for (int b = 0; b < 32; ++b) lds[(kg * 32 + b) * 64 + col] = acc[b];
    __syncthreads();
    for (int o = tid; o < 2048; o += 512) { const int b = o >> 6, cc = o & 63; float s = 0.f;
#pragma unroll
        for (int q = 0; q < 8; ++q) s += lds[(q * 32 + b) * 64 + cc];
        ((float*)(argws() + WS_MOD))[(size_t)(l * 32 + b) * 6144 + cb * 64 + cc] = s + argf(4)[l * 6144 + cb * 64 + cc]; }
    __syncthreads();
}
__device__ __forceinline__ void modulate_phase(const float* X, const float* sh, const float* sc, bf16_t* H, int gtid, int gthreads) {
    for (int idx = gtid; idx < T * 128; idx += gthreads) {
        const int row = idx >> 7, c = (idx & 127) * 8, b = row >> 11;
        const f32x4 x0 = *(const f32x4*)(X + (size_t)row * D + c), x1 = *(const f32x4*)(X + (size_t)row * D + c + 4);
        const f32x4 s0 = *(const f32x4*)(sc + b * 6144 + c), s1 = *(const f32x4*)(sc + b * 6144 + c + 4);
        const f32x4 h0 = *(const f32x4*)(sh + b * 6144 + c), h1 = *(const f32x4*)(sh + b * 6144 + c + 4);
        const f32x4 v0 = x0 * (s0 + 1.f) + h0, v1 = x1 * (s1 + 1.f) + h1;
        u32x4 w; w.x = pk2(v0[0], v0[1]); w.y = pk2(v0[2], v0[3]); w.z = pk2(v1[0], v1[1]); w.w = pk2(v1[2], v1[3]);
        *(u32x4*)(H + (size_t)row * D + c) = w;
    }
}
__device__ __forceinline__ void ln_phase(const float* Z, float* Xo, bf16_t* H, float* stats, const float* w, const float* bv, const float* sh, const float* sc, int gw, int ngw, int lane) {
    const int rpw = (T + ngw - 1) / ngw, rbeg = gw * rpw, rend = (rbeg + rpw < T) ? (rbeg + rpw) : T;
    f32x4 wv[4], bb[4], s4[4], h4[4];
#pragma unroll
    for (int j = 0; j < 4; ++j) { const int c = 4 * lane + 256 * j; wv[j] = *(const f32x4*)(w + c); bb[j] = *(const f32x4*)(bv + c); s4[j] = (f32x4){0.f, 0.f, 0.f, 0.f}; h4[j] = s4[j]; }
    int bcur = -1;
    for (int row0 = rbeg; row0 < rend; row0 += 4) {
        f32x4 v[4][4];
#pragma unroll
        for (int u = 0; u < 4; ++u) { const int row = row0 + u;
            if (row < rend) { const float* zr = Z + (size_t)row * D + 4 * lane;
#pragma unroll
                for (int j = 0; j < 4; ++j) v[u][j] = *(const f32x4*)(zr + 256 * j); } }
#pragma unroll
        for (int u = 0; u < 4; ++u) { const int row = row0 + u;
            if (row < rend) { const int b = row >> 11;
                if (H && b != bcur) { bcur = b;
#pragma unroll
                    for (int j = 0; j < 4; ++j) { const int c = 4 * lane + 256 * j; s4[j] = *(const f32x4*)(sc + b * 6144 + c) + 1.f; h4[j] = *(const f32x4*)(sh + b * 6144 + c); } }
                float s = 0.f;
#pragma unroll
                for (int j = 0; j < 4; ++j) s += (v[u][j][0] + v[u][j][1]) + (v[u][j][2] + v[u][j][3]);
                const float mean = wave_sum(s) * (1.f / D); float s2 = 0.f;
#pragma unroll
                for (int j = 0; j < 4; ++j) { v[u][j] = v[u][j] - mean; s2 += (v[u][j][0] * v[u][j][0] + v[u][j][1] * v[u][j][1]) + (v[u][j][2] * v[u][j][2] + v[u][j][3] * v[u][j][3]); }
                const float rstd = rsqrtf(wave_sum(s2) * (1.f / D) + EPS);
                if (stats && lane == 0) { stats[2 * row] = mean; stats[2 * row + 1] = rstd; }
#pragma unroll
                for (int j = 0; j < 4; ++j) { const int c = 4 * lane + 256 * j;
                    const f32x4 xo = v[u][j] * rstd * wv[j] + bb[j];
                    if (Xo) *(f32x4*)(Xo + (size_t)row * D + c) = xo;
                    if (H) { const f32x4 hv = xo * s4[j] + h4[j];
                        u32x2 o; o.x = pk2(hv[0], hv[1]); o.y = pk2(hv[2], hv[3]);
                        *(u32x2*)(H + (size_t)row * D + c) = o; } } } }
    }
}
__device__ __forceinline__ void ssd_norm_phase(bf16_t* Y, const float* nw, int gw, int ngw, int lane) {
    const f32x4 wv = *(const f32x4*)(nw + 4 * lane);
    for (int row0 = gw; row0 < T; row0 += 8 * ngw) {
        u32x2 r[8];
#pragma unroll
        for (int u = 0; u < 8; ++u) { const int row = row0 + u * ngw; if (row < T) r[u] = *(const u32x2*)(Y + (size_t)row * D + 4 * lane); }
#pragma unroll
        for (int u = 0; u < 8; ++u) { const int row = row0 + u * ngw;
            if (row < T) {
                const float a0 = __uint_as_float(r[u].x << 16), a1 = __uint_as_float(r[u].x & 0xffff0000u), a2 = __uint_as_float(r[u].y << 16), a3 = __uint_as_float(r[u].y & 0xffff0000u);
                const float ss = wave_sum((a0 * a0 + a1 * a1) + (a2 * a2 + a3 * a3));
                const float rstd = rsqrtf(ss * (1.f / 256.f) + EPS);
                u32x2 o; o.x = pk2(a0 * rstd * wv[0], a1 * rstd * wv[1]); o.y = pk2(a2 * rstd * wv[2], a3 * rstd * wv[3]);
                *(u32x2*)(Y + (size_t)row * D + 4 * lane) = o; } }
    }
}


constexpr int TC = 64, NCH = SEQ / TC;
typedef __amdgpu_buffer_rsrc_t rsrc_t;
__device__ __forceinline__ rsrc_t mk_rsrc(const void* p) { return __builtin_amdgcn_make_buffer_rsrc((void*)p, 0, 0x7fffffff, 0x00020000); }
__device__ __forceinline__ unsigned bl16(rsrc_t r, int voff_bytes, int soff_bytes) { return (unsigned)__builtin_amdgcn_raw_buffer_load_b16(r, voff_bytes, soff_bytes, 0); }
__device__ __forceinline__ float bfu2f(unsigned v) { return __uint_as_float(v << 16); }
__device__ __forceinline__ void bs16(rsrc_t r, bf16_t v, int voff_bytes, int soff_bytes) { __builtin_amdgcn_raw_buffer_store_b16(v, r, voff_bytes, soff_bytes, 0); }

__device__ __forceinline__ void gla_job(const bf16_t* P, bf16_t* Y, int l, int b, int h, LAS float* lds, int wave_s) {
    const int tid = wave_s * 64 + lv(lane_id());
    LAS float* GL = lds + 20480; LAS float* Yl = lds + 21504;
    const int wave = tid >> 6, lane = tid & 63, k0 = (lane & 3) * 8, pp = (wave & 3) * 16 + (lane >> 2);
    const int ki = tid & 31, t2 = tid & 255;
    float wg[16];
#pragma unroll
    for (int j = 0; j < 16; ++j) wg[j] = argf(20)[l * 2048 + j * 128 + h * 32 + ki];
    const float bgv = argf(21)[l * 128 + h * 32 + ki];
    const float nw = argf(22)[l * 256 + h * 64 + lane];
    float S[8];
#pragma unroll
    for (int i = 0; i < 8; ++i) S[i] = 0.f;
    unsigned gln[4], qn[8], kn[8], vn[16], rn[16], rc[16];
    const rsrc_t rs = mk_rsrc(P);
    const int rb2 = b * SEQ * INP * 2;
    const rsrc_t ry = mk_rsrc(Y); const int yb2 = b * SEQ * D * 2, voY = ((wave & 3) * D + 768 + h * 64 + lane) * 2;
    const int voG = ((t2 >> 4) * INP + C_GLA_GL + (t2 & 15)) * 2, voQ = ((t2 >> 5) * INP + h * 32 + ki) * 2, voV = ((wave & 3) * INP + h * 64 + lane) * 2;
#define GLA_LOAD(t0_) do { const int so__ = rb2 + (t0_) * INP * 2; \
        _Pragma("unroll") for (int i = 0; i < 4; ++i) gln[i] = bl16(rs, voG, so__ + 16 * i * INP * 2); \
        _Pragma("unroll") for (int i = 0; i < 8; ++i) { const int s2 = so__ + 8 * i * INP * 2; qn[i] = bl16(rs, voQ, s2 + C_GLA_Q * 2); kn[i] = bl16(rs, voQ, s2 + C_GLA_K * 2); } \
        _Pragma("unroll") for (int i = 0; i < 16; ++i) vn[i] = bl16(rs, voV, so__ + (4 * i * INP + C_GLA_V) * 2); } while (0)
#define GLA_LOADR(t0_) do { const int so__ = rb2 + (t0_) * INP * 2; _Pragma("unroll") for (int i = 0; i < 16; ++i) rn[i] = bl16(rs, voV, so__ + (4 * i * INP + C_GLA_R) * 2); } while (0)
#define GLA_STAGE(set_) do { LAS float* B__ = lds + (set_) * 10240; \
        _Pragma("unroll") for (int i = 0; i < 4; ++i) GL[((t2 >> 4) + 16 * i) * 16 + (t2 & 15)] = bfu2f(gln[i]); \
        _Pragma("unroll") for (int i = 0; i < 8; ++i) { const int t = (t2 >> 5) + 8 * i; B__[t * 32 + ki] = bfu2f(qn[i]) * 0.17677669529663687f; B__[2048 + t * 32 + ki] = bfu2f(kn[i]); } \
        _Pragma("unroll") for (int i = 0; i < 16; ++i) { const int t = (wave & 3) + 4 * i; B__[6144 + t * 64 + lane] = bfu2f(vn[i]); } } while (0)
#define GLA_FINAL(cprev_) do { const int cp__ = (cprev_); const LAS float* Yp__ = Yl + (cp__ & 1) * 4096; \
        _Pragma("unroll") for (int i = 0; i < 16; ++i) { const int t = (wave & 3) + 4 * i; const float y = Yp__[t * 64 + lane]; \
            const float ms = wave_sum(y * y) * (1.f / 64.f); \
            bs16(ry, f2bf(y * rsqrtf(ms + EPS) * nw * siluf_(bfu2f(rc[i]))), voY, yb2 + (cp__ * TC + 4 * i) * D * 2); } } while (0)
    if (wave_s >= 4) { GLA_LOAD(0); GLA_LOADR(0); GLA_STAGE(0); GLA_LOAD(TC); }
    __syncthreads();
    for (int c = 0; c < NCH; ++c) {
        const int t0 = c * TC;
        LAS float* Bs = lds + (c & 1) * 10240;
#pragma unroll
        for (int i = 0; i < 4; ++i) { const int t = (tid >> 5) + 16 * i; float s = bgv;
#pragma unroll
            for (int j = 0; j < 16; ++j) s += GL[t * 16 + j] * wg[j];
            const float ls = fminf(s, 0.f) - __logf(1.f + __expf(-fabsf(s)));
            Bs[4096 + t * 32 + ki] = __expf(ls * (1.f / 16.f)); }
        __syncthreads();
        if (wave_s < 4) {
            LAS float* ydst = (lane & 3) == 0 ? (Yl + (c & 1) * 4096 + pp) : (lds + (LDS_XB + 256) / 4 + lane); const int ystride = (lane & 3) == 0 ? 64 : 0;
            f32x4 a0_[2], k0_[2], q0_[2], a1_[2], k1_[2], q1_[2]; float v0_, v1_;
#define GLA_LD(t_, aq, kq, qq, vq) do { const int tt_ = (t_); vq = Bs[6144 + tt_ * 64 + pp]; \
            _Pragma("unroll") for (int u = 0; u < 2; ++u) { aq[u] = *(const LAS f32x4*)(Bs + 4096 + tt_ * 32 + k0 + 4 * u); kq[u] = *(const LAS f32x4*)(Bs + 2048 + tt_ * 32 + k0 + 4 * u); qq[u] = *(const LAS f32x4*)(Bs + tt_ * 32 + k0 + 4 * u); } } while (0)
#define GLA_STEP(t_, aq, kq, qq, vq) do { float y = 0.f; \
            _Pragma("unroll") for (int u = 0; u < 2; ++u) _Pragma("unroll") for (int j = 0; j < 4; ++j) { S[4 * u + j] = aq[u][j] * S[4 * u + j] + kq[u][j] * vq; y += qq[u][j] * S[4 * u + j]; } \
            y += dpp_f(y, 0xB1); y += dpp_f(y, 0x4E); ydst[(t_) * ystride] = y; } while (0)
            GLA_LD(0, a0_, k0_, q0_, v0_);
            for (int t = 0; t < TC; t += 2) {
                GLA_LD(t + 1, a1_, k1_, q1_, v1_);
                GLA_STEP(t, a0_, k0_, q0_, v0_);
                GLA_LD(t + 2 < TC ? t + 2 : t + 1, a0_, k0_, q0_, v0_);
                GLA_STEP(t + 1, a1_, k1_, q1_, v1_);
            }
#undef GLA_LD
#undef GLA_STEP
        } else {
            if (c > 0) GLA_FINAL(c - 1);
#pragma unroll
            for (int i = 0; i < 16; ++i) rc[i] = rn[i];
            if (c + 1 < NCH) { GLA_LOADR(t0 + TC); GLA_STAGE((c + 1) & 1); if (c + 2 < NCH) GLA_LOAD(t0 + 2 * TC); }
        }
        __syncthreads();
    }
    if (wave_s >= 4) GLA_FINAL(NCH - 1);
    __syncthreads();
#undef GLA_LOAD
#undef GLA_LOADR
#undef GLA_STAGE
#undef GLA_FINAL
}

__device__ __forceinline__ void lru_job(const bf16_t* P, bf16_t* Y, int l, int b, int kb, LAS float* lds, int wave_s) {
    const int tid = wave_s * 64 + lv(lane_id());
    LAS float* XC = lds; LAS float* Aa = lds + 4096; LAS float* Uu = lds + 8192; LAS float* Hh = lds + 12288;
    const int j = tid & 63, tg = tid >> 6, ch = kb * 64 + j;
    typedef float f32x2_t __attribute__((ext_vector_type(2)));
    f32x2_t wax[64];
    { const float* wap = argf(15) + l * 16384; const float* wxp = argf(17) + l * 16384;
#pragma unroll
      for (int i = 0; i < 64; ++i) { wax[i].x = wap[(kb * 64 + i) * 64 + j]; wax[i].y = wxp[(kb * 64 + i) * 64 + j]; } }
    const float ba = argf(16)[l * 256 + ch], bx = argf(18)[l * 256 + ch], spl = softplusf_(-argf(19)[l * 256 + ch]);
    const float* cwp = argf(13) + l * 1024;
    const float cw0 = cwp[ch], cw1 = cwp[256 + ch], cw2 = cwp[512 + ch], cw3 = cwp[768 + ch], cb = argf(14)[l * 256 + ch];
    float hs = 0.f;
    unsigned xn[8][4], gtn[8], gtc[8];
    const rsrc_t rs = mk_rsrc(P);
    const int rb2 = b * SEQ * INP * 2;
    const rsrc_t ry = mk_rsrc(Y); const int yb2 = b * SEQ * D * 2, voY = (tg * D + 512 + ch) * 2;
    const int voX = (tg * INP + ch) * 2;
#define LRU_LOAD(t0_) do { const int t0__ = (t0_); const int so__ = rb2 + t0__ * INP * 2; \
        _Pragma("unroll") for (int i = 0; i < 8; ++i) { gtn[i] = bl16(rs, voX, so__ + (8 * i * INP + C_LRU_G) * 2); \
            _Pragma("unroll") for (int k = 0; k < 4; ++k) { \
                if (t0__ == 0 && i == 0 && k < 3) { const int tt = tg - 3 + k; const unsigned v = bl16(rs, (ch + (tt >= 0 ? tt : 0) * INP) * 2, rb2 + C_LRU_X * 2); xn[i][k] = tt >= 0 ? v : 0u; } \
                else xn[i][k] = bl16(rs, voX, so__ + ((8 * i - 3 + k) * INP + C_LRU_X) * 2); } } } while (0)
    LRU_LOAD(0);
    for (int c = 0; c < NCH; ++c) {
        const int t0 = c * TC;
#pragma unroll
        for (int i = 0; i < 8; ++i) { XC[(tg + 8 * i) * 64 + j] = cw0 * bfu2f(xn[i][0]) + cw1 * bfu2f(xn[i][1]) + cw2 * bfu2f(xn[i][2]) + cw3 * bfu2f(xn[i][3]) + cb; gtc[i] = gtn[i]; }
        __syncthreads();
        if (c + 1 < NCH) LRU_LOAD(t0 + TC);
#pragma unroll 1
        for (int tt = 0; tt < 8; ++tt) { const int t = tg * 8 + tt; f32x2_t dd = {ba, bx};
#pragma unroll
            for (int i4 = 0; i4 < 16; ++i4) { const f32x4 xv = *(const LAS f32x4*)(XC + t * 64 + 4 * i4);
#pragma unroll
                for (int q = 0; q < 4; ++q) { const f32x2_t xb = {xv[q], xv[q]}; dd = __builtin_elementwise_fma(xb, wax[4 * i4 + q], dd); } }
            const float rg = sigmoidf_(dd.x), ig = sigmoidf_(dd.y);
            const float la = -8.f * rg * spl;
            const float av = __expf(la);
            Aa[t * 64 + j] = av;
            Uu[t * 64 + j] = sqrtf(fmaxf(1.f - av * av, 0.f)) * (ig * XC[t * 64 + j]); }
        __syncthreads();
        if (tid < 64) {
            for (int tb = 0; tb < TC; tb += 8) { float av[8], uv[8];
#pragma unroll
                for (int k = 0; k < 8; ++k) { av[k] = Aa[(tb + k) * 64 + j]; uv[k] = Uu[(tb + k) * 64 + j]; }
#pragma unroll
                for (int k = 0; k < 8; ++k) { hs = av[k] * hs + uv[k]; Hh[(tb + k) * 64 + j] = hs; } }
        }
        __syncthreads();
#pragma unroll
        for (int i = 0; i < 8; ++i) { const int t = tg + 8 * i;
            const float gt = bfu2f(gtc[i]);
            const float ge = gt * sigmoidf_(1.5957691216057308f * (gt + 0.044715f * gt * gt * gt));
            bs16(ry, f2bf(Hh[t * 64 + j] * ge), voY, yb2 + (t0 + 8 * i) * D * 2); }
    }
    __syncthreads();
#undef LRU_LOAD
}


__device__ __forceinline__ unsigned pk2_c(float lo, float hi) {
    unsigned a = __float_as_uint(lo), b = __float_as_uint(hi);
    a += 0x7fffu + ((a >> 16) & 1u); b += 0x7fffu + ((b >> 16) & 1u);
    return (a >> 16) | (b & 0xffff0000u);
}
__device__ __forceinline__ bf16x8 mfrag(const LAS bf16_t* base, int ld, int row0, int k0, int r, int q) { return *(const LAS bf16x8*)(base + (row0 + r) * ld + k0 + 8 * q); }
template <int N>
__device__ __forceinline__ void sd_chunk_core(LAS bf16_t* Qs, LAS bf16_t* Ks, LAS bf16_t* ST, LAS bf16_t* KdT, LAS bf16_t* VT, LAS bf16_t* Gs, LAS float* Yl, const LAS float* cum,
                                              f32x4 (&Sacc)[N / 32], int wave, int lane) {
    constexpr int LDN = N + 8, NK = N / 32, NST = N / 32;
    const int r = lane & 15, q = lane >> 4, ti = wave >> 1, half = wave & 1;
    bf16x8 aQ[NK];
#pragma unroll
    for (int k = 0; k < NK; ++k) aQ[k] = mfrag(Qs, LDN, 16 * ti, 32 * k, r, q);
#pragma unroll
    for (int sj = 0; sj < 2; ++sj) { const int si = 2 * half + sj;
        f32x4 acc = {0.f, 0.f, 0.f, 0.f};
        if (si <= ti) {
#pragma unroll
            for (int k = 0; k < NK; ++k) acc = __builtin_amdgcn_mfma_f32_16x16x32_bf16(aQ[k], mfrag(Ks, LDN, 16 * si, 32 * k, r, q), acc, 0, 0, 0);
        }
        const int sc = 16 * si + r; const float cs = cum[sc];
#pragma unroll
        for (int j = 0; j < 4; ++j) { const int t = 16 * ti + 4 * q + j;
            const float v = (si <= ti && sc <= t) ? acc[j] * __expf(cum[t] - cs) : 0.f;
            Gs[t * 72 + sc] = f2bf(v); } }
    f32x4 cB[2];
#pragma unroll
    for (int pj = 0; pj < 2; ++pj) { const int pi = 2 * half + pj; cB[pj] = (f32x4){0.f, 0.f, 0.f, 0.f};
#pragma unroll
        for (int k = 0; k < NK; ++k) cB[pj] = __builtin_amdgcn_mfma_f32_16x16x32_bf16(aQ[k], mfrag(ST, LDN, 16 * pi, 32 * k, r, q), cB[pj], 0, 0, 0); }
    __syncthreads();
    { bf16x8 aG[2];
#pragma unroll
      for (int kk = 0; kk < 2; ++kk) aG[kk] = mfrag(Gs, 72, 16 * ti, 32 * kk, r, q);
#pragma unroll
      for (int pj = 0; pj < 2; ++pj) { const int pi = 2 * half + pj; f32x4 cA = {0.f, 0.f, 0.f, 0.f};
#pragma unroll
          for (int kk = 0; kk < 2; ++kk) cA = __builtin_amdgcn_mfma_f32_16x16x32_bf16(aG[kk], mfrag(VT, 72, 16 * pi, 32 * kk, r, q), cA, 0, 0, 0);
#pragma unroll
          for (int j = 0; j < 4; ++j) { const int t = 16 * ti + 4 * q + j; Yl[t * 64 + 16 * pi + r] = cA[j] + __expf(cum[t]) * cB[pj][j]; } } }
    { const float dL = __expf(cum[63]);
      const int ni = (N == 128) ? wave : (wave >> 1);
      bf16x8 aK[2];
#pragma unroll
      for (int kk = 0; kk < 2; ++kk) aK[kk] = mfrag(KdT, 72, 16 * ni, 32 * kk, r, q);
#pragma unroll
      for (int u = 0; u < NST; ++u) { const int pi = (N == 128) ? u : (2 * half + u);
          Sacc[u] = Sacc[u] * dL;
#pragma unroll
          for (int kk = 0; kk < 2; ++kk) Sacc[u] = __builtin_amdgcn_mfma_f32_16x16x32_bf16(aK[kk], mfrag(VT, 72, 16 * pi, 32 * kk, r, q), Sacc[u], 0, 0, 0);
          u32x2 w; w.x = pk2_c(Sacc[u][0], Sacc[u][1]); w.y = pk2_c(Sacc[u][2], Sacc[u][3]);
          *(LAS u32x2*)(ST + (16 * pi + r) * LDN + 16 * ni + 4 * q) = w; } }
    __syncthreads();
}

__device__ __forceinline__ void ssdm_job(const bf16_t* P, bf16_t* Y, int l, int b, int h, LAS float* lds, int wave_s) {
    const int tid = wave_s * 64 + lv(lane_id());
    const int wave = tid >> 6, lane = tid & 63, g = h >> 1;
    LAS unsigned char* L = (LAS unsigned char*)lds;
    LAS bf16_t* Qs = (LAS bf16_t*)(L); LAS bf16_t* Ks = (LAS bf16_t*)(L + 17408); LAS bf16_t* ST = (LAS bf16_t*)(L + 34816); LAS bf16_t* KdT = (LAS bf16_t*)(L + 52224);
    LAS bf16_t* VT = (LAS bf16_t*)(L + 70656); LAS bf16_t* Gs = (LAS bf16_t*)(L + 79872); LAS float* Yl = (LAS float*)(L + 89088); LAS float* Xs = (LAS float*)(L + 105472);
    LAS bf16_t* Zs = (LAS bf16_t*)(L + 121856); LAS float* cum = (LAS float*)(L + 130048); LAS float* Dt = (LAS float*)(L + 130304);
    int xi = 0;
    if (tid < 64) xi = h * 64 + tid; else if (tid < 192) xi = 256 + g * 128 + (tid - 64); else if (tid < 320) xi = 512 + g * 128 + (tid - 192);
    float cw0 = 0.f, cw1 = 0.f, cw2 = 0.f, cw3 = 0.f, cb = 0.f, r1 = 0.f, r2 = 0.f, r3 = 0.f;
    if (tid < 320) { const float* cwp = argf(6) + l * 4 * 768; cw0 = cwp[xi]; cw1 = cwp[768 + xi]; cw2 = cwp[1536 + xi]; cw3 = cwp[2304 + xi]; cb = argf(7)[l * 768 + xi]; }
    const float dsk = argf(10)[l * 4 + h];
    f32x4 Sacc[4];
#pragma unroll
    for (int u = 0; u < 4; ++u) Sacc[u] = (f32x4){0.f, 0.f, 0.f, 0.f};
    for (int i = tid; i < 64 * 136 / 2; i += 512) ((LAS unsigned*)ST)[i] = 0u;
    unsigned rn[TC];
    const rsrc_t rs = mk_rsrc(P);
    const int rb2 = b * SEQ * INP * 2;
    const rsrc_t ry = mk_rsrc(Y); const int yb2 = b * SEQ * D * 2, voY = (wave * D + h * 64 + lane) * 2;
    const int zhalf = (tid >> 6) & 1;
    const int voA = tid < 320 ? (C_SSD_XBC + xi) * 2 : (tid < 384 ? ((tid - 320) * INP + C_SSD_DT + h) * 2 : (zhalf * 32 * INP + C_SSD_Z + h * 64 + lane) * 2);
#define SSD_LOAD(t0_) do { const int so__ = rb2 + (t0_) * INP * 2; \
        if (tid < 320) { _Pragma("unroll") for (int t = 0; t < TC; ++t) rn[t] = bl16(rs, voA, so__ + t * INP * 2); } \
        else if (tid < 384) rn[0] = bl16(rs, voA, so__); \
        else { _Pragma("unroll") for (int t = 0; t < 32; ++t) rn[t] = bl16(rs, voA, so__ + t * INP * 2); } } while (0)
    SSD_LOAD(0);
    for (int c = 0; c < NCH; ++c) {
        const int t0 = c * TC;
        if (tid < 64) {
#pragma unroll
            for (int t = 0; t < TC; ++t) { const float r0 = bfu2f(rn[t]); Xs[t * 64 + tid] = siluf_(cw0 * r3 + cw1 * r2 + cw2 * r1 + cw3 * r0 + cb); r3 = r2; r2 = r1; r1 = r0;
                if ((t & 7) == 7) __builtin_amdgcn_sched_barrier(0); }
        } else if (tid < 320) {
            LAS bf16_t* dst = tid < 192 ? (Ks + (tid - 64)) : (Qs + (tid - 192));
#pragma unroll
            for (int t = 0; t < TC; ++t) { const float r0 = bfu2f(rn[t]); dst[t * 136] = f2bf(siluf_(cw0 * r3 + cw1 * r2 + cw2 * r1 + cw3 * r0 + cb)); r3 = r2; r2 = r1; r1 = r0;
                if ((t & 7) == 7) __builtin_amdgcn_sched_barrier(0); }
        } else if (tid < 384) {
            const int ln = lv(lane);
            const float dtv = softplusf_(bfu2f(rn[0]) + argf(8)[l * 4 + h]);
            float cs = -expf(argf(9)[l * 4 + h]) * dtv;
#pragma unroll
            for (int d = 1; d < 64; d <<= 1) { const float o = __shfl_up(cs, d); if (ln >= d) cs += o; }
            Dt[ln] = dtv; cum[ln] = cs;
        } else {
#pragma unroll
            for (int t = 0; t < 32; ++t) Zs[(zhalf * 32 + t) * 64 + lane] = (bf16_t)rn[t];
        }
        __syncthreads();
        if (c + 1 < NCH) SSD_LOAD(t0 + TC);
        { const float cL = cum[63];
#pragma unroll
          for (int i = 0; i < 4; ++i) { const int idx = tid + 512 * i, p = idx & 63, t = (idx >> 6) * 2;
              ((LAS unsigned*)VT)[p * 36 + (t >> 1)] = pk2(Xs[t * 64 + p] * Dt[t], Xs[(t + 1) * 64 + p] * Dt[t + 1]); }
#pragma unroll
          for (int i = 0; i < 8; ++i) { const int idx = tid + 512 * i, n = idx & 127, t = (idx >> 7) * 2;
              ((LAS unsigned*)KdT)[n * 36 + (t >> 1)] = pk2(bf2f(Ks[t * 136 + n]) * __expf(cL - cum[t]), bf2f(Ks[(t + 1) * 136 + n]) * __expf(cL - cum[t + 1])); } }
        __syncthreads();
        sd_chunk_core<128>(Qs, Ks, ST, KdT, VT, Gs, Yl, cum, Sacc, wave, lane);
#pragma unroll
        for (int i = 0; i < 8; ++i) { const int t = wave + 8 * i;
            const float y = Yl[t * 64 + lane] + Xs[t * 64 + lane] * dsk;
            bs16(ry, f2bf(y * siluf_(bf2f(Zs[t * 64 + lane]))), voY, yb2 + (t0 + 8 * i) * D * 2); }
        __syncthreads();
    }
#undef SSD_LOAD
}

__device__ __forceinline__ void retm_job(const bf16_t* P, bf16_t* Y, int l, int b, int h, LAS float* lds, int wave_s) {
    const int tid = wave_s * 64 + lv(lane_id());
    const int* positions = (const int*)argf(2);
    const int wave = tid >> 6, lane = tid & 63;
    LAS unsigned char* L = (LAS unsigned char*)lds;
    LAS bf16_t* Qs = (LAS bf16_t*)(L); LAS bf16_t* Ks = (LAS bf16_t*)(L + 9216); LAS bf16_t* ST = (LAS bf16_t*)(L + 18432); LAS bf16_t* KdT = (LAS bf16_t*)(L + 27648);
    LAS bf16_t* VT = (LAS bf16_t*)(L + 36864); LAS bf16_t* Gs = (LAS bf16_t*)(L + 46080); LAS float* Yl = (LAS float*)(L + 55296); LAS float* cum = (LAS float*)(L + 71680);
    const float lg = log1pf(-exp2f(-5.f - (float)h));
    const int ri = tid & 31;
    const double inv_freq = (double)exp2f(-(float)ri * 0.41524101186092033f);
    const float nw = argf(12)[l * 256 + h * 64 + lane];
    f32x4 Sacc[2];
    Sacc[0] = (f32x4){0.f, 0.f, 0.f, 0.f}; Sacc[1] = (f32x4){0.f, 0.f, 0.f, 0.f};
    for (int i = tid; i < 64 * 72 / 2; i += 512) ((LAS unsigned*)ST)[i] = 0u;
    if (tid < 64) cum[tid] = (float)(tid + 1) * lg;
    unsigned q1n[4], q2n[4], k1n[4], k2n[4], vn[8], gn[8], gc[8]; int posn[4];
    const rsrc_t rs = mk_rsrc(P);
    const int rb2 = b * SEQ * INP * 2;
    const rsrc_t ry = mk_rsrc(Y); const int yb2 = b * SEQ * D * 2, voY = (wave * D + 256 + h * 64 + lane) * 2;
    const int voR = ((tid >> 5) * INP + h * 64 + ri) * 2, voV = (wave * INP + h * 64 + lane) * 2, voV2 = (2 * wave * INP + h * 64 + lane) * 2;
#define RET_LOAD(t0_) do { const int t0__ = (t0_); const int so__ = rb2 + t0__ * INP * 2; \
        _Pragma("unroll") for (int i = 0; i < 4; ++i) { const int s2 = so__ + 16 * i * INP * 2; \
            posn[i] = positions[b * SEQ + t0__ + (tid >> 5) + 16 * i]; q1n[i] = bl16(rs, voR, s2 + C_RET_Q * 2); q2n[i] = bl16(rs, voR, s2 + (C_RET_Q + 32) * 2); \
            k1n[i] = bl16(rs, voR, s2 + C_RET_K * 2); k2n[i] = bl16(rs, voR, s2 + (C_RET_K + 32) * 2); } \
        _Pragma("unroll") for (int i = 0; i < 8; ++i) { vn[i] = bl16(rs, voV2, so__ + ((16 * (i >> 1) + (i & 1)) * INP + C_RET_V) * 2); gn[i] = bl16(rs, voV, so__ + (8 * i * INP + C_RET_G) * 2); } } while (0)
    RET_LOAD(0);
    for (int c = 0; c < NCH; ++c) {
        const int t0 = c * TC;
#pragma unroll
        for (int i = 0; i < 4; ++i) { const int t = (tid >> 5) + 16 * i;
            const double ang = (double)posn[i] * inv_freq;
            const double nrev = rint(ang * 0.15915494309189535);
            const float red = (float)fma(-nrev, 6.283185307179586, ang);
            const float cs = cosf(red), sn = sinf(red);
            const float q1 = bfu2f(q1n[i]), q2 = bfu2f(q2n[i]), k1 = bfu2f(k1n[i]) * 0.125f, k2 = bfu2f(k2n[i]) * 0.125f;
            Qs[t * 72 + ri] = f2bf(q1 * cs - q2 * sn); Qs[t * 72 + 32 + ri] = f2bf(q2 * cs + q1 * sn);
            Ks[t * 72 + ri] = f2bf(k1 * cs - k2 * sn); Ks[t * 72 + 32 + ri] = f2bf(k2 * cs + k1 * sn); }
#pragma unroll
        for (int ip = 0; ip < 4; ++ip) { ((LAS unsigned*)VT)[lane * 36 + wave + 8 * ip] = pk2(bfu2f(vn[2 * ip]), bfu2f(vn[2 * ip + 1])); }
#pragma unroll
        for (int i = 0; i < 8; ++i) gc[i] = gn[i];
        __syncthreads();
        if (c + 1 < NCH) RET_LOAD(t0 + TC);
        { const float cL = cum[63];
#pragma unroll
          for (int i = 0; i < 4; ++i) { const int idx = tid + 512 * i, n = idx & 63, t = (idx >> 6) * 2;
              ((LAS unsigned*)KdT)[n * 36 + (t >> 1)] = pk2(bf2f(Ks[t * 72 + n]) * __expf(cL - cum[t]), bf2f(Ks[(t + 1) * 72 + n]) * __expf(cL - cum[t + 1])); } }
        __syncthreads();
        sd_chunk_core<64>(Qs, Ks, ST, KdT, VT, Gs, Yl, cum, Sacc, wave, lane);
#pragma unroll
        for (int i = 0; i < 8; ++i) { const int t = wave + 8 * i; const float y = Yl[t * 64 + lane];
            const float mean = wave_sum(y) * (1.f / 64.f), d = y - mean;
            const float var = wave_sum(d * d) * (1.f / 64.f);
            bs16(ry, f2bf(d * rsqrtf(var + EPS) * nw * siluf_(bfu2f(gc[i]))), voY, yb2 + (t0 + 8 * i) * D * 2); }
        __syncthreads();
    }
#undef RET_LOAD
}

#define XB_TMO      128
#define XB_XCNT(j)  (256  + 64 * (j))
#define XB_XSUB(j)  (1280 + 64 * (j))
#define XB_XGEN(j)  (2304 + 64 * (j))
#define XB_TOP      3328
#define XB_TOPGEN   3392
#define XCD_BAR_WORDS 3456
#define XB_SPIN_CAP (1u << 22)
__device__ __forceinline__ unsigned xb_ld(unsigned* p)              { return __hip_atomic_load(p, __ATOMIC_RELAXED, __HIP_MEMORY_SCOPE_AGENT); }
__device__ __forceinline__ unsigned xb_add(unsigned* p, unsigned v) { return __hip_atomic_fetch_add(p, v, __ATOMIC_RELAXED, __HIP_MEMORY_SCOPE_AGENT); }
__device__ __forceinline__ unsigned xb_xcc_id() { return (unsigned)__builtin_amdgcn_s_getreg((3 << 11) | 20) & 0xFu; }
#define XB_SPIN(cond, bar) do { unsigned _sp = 0; while (cond) { __builtin_amdgcn_s_sleep(1); \
    if ((++_sp & 255u) == 0u) { if (xb_ld(&(bar)[XB_TMO])) break; if (_sp > XB_SPIN_CAP) { atomicAdd(&(bar)[XB_TMO], 1u); break; } } } } while (0)
__device__ __forceinline__ void xcd_barrier_post(unsigned* bar, int wave_s) { if (wave_s == 0 && lane_id() == 0) (void)xb_add(&bar[XB_XCNT(xb_xcc_id())], 1u); }
__device__ __forceinline__ void xcd_barrier_complete(unsigned* bar, unsigned x, unsigned& nloc, unsigned& nx) {
    const unsigned G = gridDim.x * gridDim.y * gridDim.z;
    unsigned sum, cnt, mine, sp = 0u;
    for (;;) {
        sum = 0u; cnt = 0u; mine = 0u;
#pragma unroll
        for (unsigned j = 0; j < 16; ++j) { const unsigned c = xb_ld(&bar[XB_XCNT(j)]); sum += c; cnt += (c > 0u) ? 1u : 0u; mine = (j == x) ? c : mine; }
        if (sum == G) break;
        __builtin_amdgcn_s_sleep(1);
        if ((++sp & 255u) == 0u) { if (xb_ld(&bar[XB_TMO])) break; if (sp > XB_SPIN_CAP) { atomicAdd(&bar[XB_TMO], 1u); break; } }
    }
    nloc = mine > 0u ? mine : 1u; nx = cnt > 0u ? cnt : 1u;
}
__device__ __forceinline__ void xcd_barrier(unsigned* bar, volatile LAS unsigned* st, int wave_s) {
    asm volatile("s_waitcnt vmcnt(0)" ::: "memory");
    __syncthreads();
    if (wave_s == 0 && lane_id() == 0) {
        const unsigned x = xb_xcc_id();
        __builtin_amdgcn_s_waitcnt(0);
        unsigned nloc = st[0], nx = st[1];
        if (nloc == 0u) { xcd_barrier_complete(bar, x, nloc, nx); st[0] = nloc; st[1] = nx; }
        const unsigned old = xb_add(&bar[XB_XSUB(x)], 1u);
        const unsigned gen = old / nloc;
        if (old + 1u == (gen + 1u) * nloc) {
            __builtin_amdgcn_fence(__ATOMIC_RELEASE, "agent");
            asm volatile("s_waitcnt vmcnt(0)" ::: "memory");
            const unsigned og = xb_add(&bar[XB_TOP], 1u);
            const unsigned tg = og / nx;
            if (og + 1u == (tg + 1u) * nx) xb_add(&bar[XB_TOPGEN], 1u);
            else XB_SPIN(xb_ld(&bar[XB_TOPGEN]) == tg, bar);
            __builtin_amdgcn_fence(__ATOMIC_ACQUIRE, "agent");
            xb_add(&bar[XB_XGEN(x)], 1u);
            asm volatile("s_waitcnt vmcnt(0)" ::: "memory");
        } else {
            XB_SPIN(xb_ld(&bar[XB_XGEN(x)]) == gen, bar);
            __builtin_amdgcn_fence(__ATOMIC_ACQUIRE, "agent");
            asm volatile("s_waitcnt vmcnt(0)" ::: "memory");
        }
    }
    __syncthreads();
}
#define GRID_BAR() xcd_barrier((unsigned*)(argws() + WS_BAR), (volatile LAS unsigned*)(lds + LDS_XB), wave_s)

struct Args {
    const float* in[30];
    float* out; unsigned char* ws;
};
#define PH_IDS const int lane = lv(lane_id()), wave = wave_s, tid = wave * 64 + lane, bid = ls(blockIdx.x), G = ls(gridDim.x); (void)lane; (void)wave; unsigned char* ws = argws(); (void)ws;

__device__ __forceinline__ void layer_phases(const int l, LAS unsigned char* lds, const int wave_s) {
    LAS float* ldsf = (LAS float*)lds;
    { PH_IDS
      pg8::StaticOrder S; pg8::Gemm g{(const bf16_t*)(ws + WS_H), (const bf16_t*)(ws + WS_WIN) + (size_t)l * INP * D, T, INP, D}; S.init(T, INP, G, bid);
      pg8::EpiP E{(bf16_t*)(ws + WS_P), INP}; pg8::gemm_phase(lds, g, S, E, wave_s); }
    GRID_BAR();
    { PH_IDS
      const bf16_t* Pj = (const bf16_t*)(ws + WS_P); bf16_t* Y = (bf16_t*)(ws + WS_H);
      for (int job = bid; job < 256; job += G) {
          const int i = job & 127, b = i >> 2, h = i & 3;
          if (job < 128) { ssdm_job(Pj, Y, l, b, h, ldsf, wave_s); gla_job(Pj, Y, l, b, h, ldsf, wave_s); }
          else { retm_job(Pj, Y, l, b, h, ldsf, wave_s); lru_job(Pj, Y, l, b, h, ldsf, wave_s); }
      } }
    GRID_BAR();
    { PH_IDS
      ssd_norm_phase((bf16_t*)(ws + WS_H), argf(11) + l * 256, bid * 8 + wave, G * 8, lane); }
    GRID_BAR();
    { PH_IDS
      float* X = (float*)(ws + WS_X); const float* modl = (const float*)(ws + WS_MOD) + (size_t)l * NB * 6144;
      pg8::StaticOrder S; pg8::Gemm g{(const bf16_t*)(ws + WS_H), (const bf16_t*)(ws + WS_WOUT) + (size_t)l * D * D, T, D, D}; S.init(T, D, G, bid, 8);
      const float* st = l == 0 ? (const float*)nullptr : (const float*)(ws + WS_STATS);
      pg8::EpiRes E{l == 0 ? argf(0) : (const float*)X, X, modl + 2048, st, argf(28), argf(29)}; pg8::gemm_phase(lds, g, S, E, wave_s); }
    GRID_BAR();
    { PH_IDS
      float* X = (float*)(ws + WS_X); const float* modl = (const float*)(ws + WS_MOD) + (size_t)l * NB * 6144;
      ln_phase(X, (float*)nullptr, (bf16_t*)(ws + WS_H), (float*)(ws + WS_STATS), argf(24) + l * D, argf(25) + l * D, modl + 3072, modl + 4096, bid * 8 + wave, G * 8, lane); }
    GRID_BAR();
    { PH_IDS
      pg8::StaticOrder S; pg8::Gemm g{(const bf16_t*)(ws + WS_H), (const bf16_t*)(ws + WS_WUP) + (size_t)l * NUP * D, T, NUP, D}; S.init(T, NUP, G, bid);
      pg8::EpiSwiglu E{(bf16_t*)(ws + WS_P)}; pg8::gemm_phase(lds, g, S, E, wave_s); }
    GRID_BAR();
    { PH_IDS
      float* X = (float*)(ws + WS_X); const float* modl = (const float*)(ws + WS_MOD) + (size_t)l * NB * 6144;
      pg8::StaticOrder S; pg8::Gemm g{(const bf16_t*)(ws + WS_P), (const bf16_t*)(ws + WS_WDN) + (size_t)l * D * DFF, T, D, DFF}; S.init(T, D, G, bid, 8);
      pg8::EpiRes E{X, X, modl + 5120, (const float*)(ws + WS_STATS), argf(24) + l * D, argf(25) + l * D}; pg8::gemm_phase(lds, g, S, E, wave_s); }
    GRID_BAR();
    { PH_IDS
      float* X = (float*)(ws + WS_X); const float* mod1 = (const float*)(ws + WS_MOD) + (size_t)NB * 6144;
      if (l == 0) ln_phase(X, (float*)nullptr, (bf16_t*)(ws + WS_H), (float*)(ws + WS_STATS), argf(28), argf(29), mod1, mod1 + 1024, bid * 8 + wave, G * 8, lane);
      else ln_phase(X, argout(), (bf16_t*)nullptr, (float*)nullptr, argf(28) + D, argf(29) + D, nullptr, nullptr, bid * 8 + wave, G * 8, lane); }
}

__global__ void __launch_bounds__(512, 2) fwd_megakernel(Args a_unused) {
    extern __shared__ __attribute__((aligned(16))) unsigned char lds_raw[];
    LAS unsigned char* lds = (LAS unsigned char*)lds_raw;
    LAS float* ldsf = (LAS float*)lds;
    cg::grid_group grid = cg::this_grid();
    const int wave_s = __builtin_amdgcn_readfirstlane((int)(threadIdx.x >> 6));
    if (threadIdx.x < 4) ((volatile LAS unsigned*)(lds + LDS_XB))[threadIdx.x] = 0u;
    __syncthreads();
    xcd_barrier_post((unsigned*)(argws() + WS_BAR), wave_s);
    { PH_IDS
      constexpr int I_IN = (INP / 64) * (D / 64), I_OUT = (D / 64) * (D / 64), I_UP = (NUP / 64) * (D / 64), I_DN = (D / 64) * (DFF / 64), I_L = I_IN + I_OUT + I_UP + I_DN;
      for (int it = bid; it < 2 * I_L; it += G) {
          const int l = it / I_L; int r = it % I_L;
          if (r < I_IN) { transpose_tile(argf(5) + (size_t)l * D * INW, INW, (bf16_t*)(ws + WS_WIN) + (size_t)l * INP * D, D, (r / 16) * 64, (r % 16) * 64, 0, ldsf, tid); continue; } r -= I_IN;
          if (r < I_OUT) { transpose_tile(argf(23) + (size_t)l * D * D, D, (bf16_t*)(ws + WS_WOUT) + (size_t)l * D * D, D, (r / 16) * 64, (r % 16) * 64, 1, ldsf, tid); continue; } r -= I_OUT;
          if (r < I_UP) { transpose_tile(argf(26) + (size_t)l * D * NUP, NUP, (bf16_t*)(ws + WS_WUP) + (size_t)l * NUP * D, D, (r / 16) * 64, (r % 16) * 64, 2, ldsf, tid); continue; } r -= I_UP;
          transpose_tile(argf(27) + (size_t)l * DFF * D, D, (bf16_t*)(ws + WS_WDN) + (size_t)l * D * DFF, DFF, (r / 44) * 64, (r % 44) * 64, 1, ldsf, tid);
      }
      for (int u = bid; u < 192; u += G) ada_unit(argf(1), argf(3), argf(4), (float*)(ws + WS_MOD), u, ldsf, tid); }
    grid.sync();
    { PH_IDS
      const float* mod = (const float*)(ws + WS_MOD);
      modulate_phase(argf(0), mod + 0, mod + 1024, (bf16_t*)(ws + WS_H), bid * 512 + tid, G * 512); }
    GRID_BAR();
    layer_phases(0, lds, wave_s);
    GRID_BAR();
    layer_phases(1, lds, wave_s);
}

extern "C" void kernel_launch(void* const* d_in, const int* in_sizes, int n_in, void* d_out, int out_size, void* d_ws, size_t ws_size, hipStream_t stream) {
    static int grid_blocks = 0;
    if (grid_blocks == 0) {
        if (n_in != 30 || ws_size < WS_TOTAL) { fprintf(stderr, "kernel_launch: unexpected n_in %d / ws_size %zu (need %zu)\n", n_in, ws_size, (size_t)WS_TOTAL); grid_blocks = -1; return; }
        int dev = 0, cus = 0, per_cu = 0;
        (void)hipGetDevice(&dev);
        (void)hipDeviceGetAttribute(&cus, hipDeviceAttributeMultiprocessorCount, dev);
        if (hipFuncSetAttribute((const void*)fwd_megakernel, hipFuncAttributeMaxDynamicSharedMemorySize, LDS_BYTES) != hipSuccess) fprintf(stderr, "kernel_launch: hipFuncSetAttribute failed\n");
        if (hipOccupancyMaxActiveBlocksPerMultiprocessor(&per_cu, (const void*)fwd_megakernel, 512, LDS_BYTES) != hipSuccess || per_cu < 1) { fprintf(stderr, "kernel_launch: occupancy query gave %d\n", per_cu); per_cu = 1; }
        (void)hipGetLastError();
        grid_blocks = cus * per_cu;
    }
    if (grid_blocks < 0) return;
    if (hipMemsetAsync((char*)d_ws + WS_BAR, 0, 16384, stream) != hipSuccess) { fprintf(stderr, "kernel_launch: memset failed\n"); return; }
    Args a{};
    for (int i = 0; i < 30; ++i) a.in[i] = (const float*)d_in[i];
    a.out = (float*)d_out; a.ws = (unsigned char*)d_ws;
    void* args[] = {&a};
    hipError_t e = hipLaunchCooperativeKernel((const void*)fwd_megakernel, dim3(grid_blocks), dim3(512), args, LDS_BYTES, stream);
    if (e != hipSuccess) fprintf(stderr, "cooperative launch failed: %s (grid %d)\n", hipGetErrorString(e), grid_blocks);
}
```

```cpp
#include <hip/hip_runtime.h>
#include <hip/hip_cooperative_groups.h>
#include <cstdio>
namespace cg = cooperative_groups;

#define LAS __attribute__((address_space(3)))
typedef unsigned short bf16_t;
typedef short bf16x8 __attribute__((ext_vector_type(8)));
typedef float f32x4 __attribute__((ext_vector_type(4)));
typedef unsigned u32x4 __attribute__((ext_vector_type(4)));
typedef unsigned u32x2 __attribute__((ext_vector_type(2)));

constexpr int T = 65536, D = 1024, SEQ = 2048, NB = 32;
constexpr int INW = 3348, INP = 3584, DFF = 2816, NUP = 5632;
constexpr float ALPHA = 1.4142135623730951f;
constexpr float EPS = 1e-5f;
constexpr int C_SSD_Z = 0, C_SSD_XBC = 256, C_SSD_DT = 1024, C_RET_Q = 1028, C_RET_K = 1284, C_RET_V = 1540, C_RET_G = 1796,
              C_LRU_G = 2052, C_LRU_X = 2308, C_GLA_Q = 2564, C_GLA_K = 2692, C_GLA_V = 2820, C_GLA_GL = 3076, C_GLA_R = 3092;
constexpr size_t SZ_WIN = (size_t)INP * D * 2, SZ_WOUT = (size_t)D * D * 2, SZ_WUP = (size_t)NUP * D * 2, SZ_WDN = (size_t)D * DFF * 2;
constexpr size_t WS_WIN = 0, WS_WOUT = WS_WIN + 2 * SZ_WIN, WS_WUP = WS_WOUT + 2 * SZ_WOUT, WS_WDN = WS_WUP + 2 * SZ_WUP,
                 WS_MOD = WS_WDN + 2 * SZ_WDN, WS_H = WS_MOD + (size_t)2 * NB * 6144 * 4, WS_X = WS_H + (size_t)T * D * 2,
                 WS_P = WS_X + (size_t)T * D * 4, WS_END = WS_P + (size_t)T * INP * 2;
constexpr size_t WS_BAR = WS_END, WS_STATS = WS_END + 16384, WS_TOTAL = WS_STATS + (size_t)T * 8;
constexpr int LDS_BYTES = 135168;
constexpr int LDS_XB = 131072;

__device__ __forceinline__ float bf2f(bf16_t v) { return __uint_as_float(((unsigned)v) << 16); }
__device__ __forceinline__ unsigned pk2(float lo, float hi) { unsigned r; asm volatile("v_cvt_pk_bf16_f32 %0, %1, %2" : "=v"(r) : "v"(lo), "v"(hi)); return r; }
__device__ __forceinline__ bf16_t f2bf(float f) { return (bf16_t)(pk2(f, 0.f) & 0xffffu); }
__device__ __forceinline__ float sigmoidf_(float x) { return __builtin_amdgcn_rcpf(1.f + __expf(-x)); }
__device__ __forceinline__ float siluf_(float x) { return x * sigmoidf_(x); }
__device__ __forceinline__ float softplusf_(float x) { return x > 20.f ? x : log1pf(expf(x)); }
__device__ __forceinline__ int lane_id() { unsigned z = 0u; asm volatile("" : "+s"(z)); return (int)__builtin_amdgcn_mbcnt_hi(~0u, __builtin_amdgcn_mbcnt_lo(~0u, z)); }
#define dpp_f(v, ctrl) __builtin_bit_cast(float, __builtin_amdgcn_update_dpp(0, __builtin_bit_cast(int, (v)), (ctrl), 0xF, 0xF, true))
__device__ __forceinline__ float wave_sum(float v) {
    v += dpp_f(v, 0xB1); v += dpp_f(v, 0x4E); v += dpp_f(v, 0x141); v += dpp_f(v, 0x140);
    const int vi = __builtin_bit_cast(int, v);
    const float s0 = __builtin_bit_cast(float, __builtin_amdgcn_readlane(vi, 0)), s1 = __builtin_bit_cast(float, __builtin_amdgcn_readlane(vi, 16)),
                s2 = __builtin_bit_cast(float, __builtin_amdgcn_readlane(vi, 32)), s3 = __builtin_bit_cast(float, __builtin_amdgcn_readlane(vi, 48));
    return (s0 + s1) + (s2 + s3);
}

typedef const unsigned long long __attribute__((address_space(4)))* karg_t;
__device__ __forceinline__ karg_t kargs() { karg_t p = (karg_t)__builtin_amdgcn_kernarg_segment_ptr(); asm volatile("" : "+s"(p)); return p; }
__device__ __forceinline__ const float* argf(int i) { return (const float*)kargs()[i]; }
__device__ __forceinline__ unsigned char* argws() { return (unsigned char*)kargs()[31]; }
__device__ __forceinline__ float* argout() { return (float*)kargs()[30]; }
__device__ __forceinline__ int lv(int v) { asm volatile("" : "+v"(v)); return v; }
__device__ __forceinline__ int ls(int v) { asm volatile("" : "+s"(v)); return v; }

namespace pg8 {
constexpr int BM = 256, BK = 64, HALF = 128, HTB = HALF * BK * 2, STAGE_BYTES = 8 * HTB, NXCD = 8, WGM = 4;
__device__ __forceinline__ int lds_byte(int r, int c) { const int st = (r >> 4) * 2 + (c >> 5), rr = r & 15, cc = c & 31, ob = rr * 64 + cc * 2; return st * 1024 + (ob ^ (((ob >> 9) & 1) << 5)); }
__device__ __forceinline__ void stage_rc(int b, int& R, int& C) { const int st = b / 1024, sb = b % 1024, swz = sb ^ (((sb >> 9) & 1) << 5); R = (st >> 1) * 16 + swz / 64; C = (st & 1) * 32 + (swz % 64) / 2; }
__device__ __forceinline__ int perm32(int rho) { const int n = rho >> 4, i = rho & 15; return 8 * (i >> 2) + 4 * n + (i & 3); }
struct Unit { int pm, pn; };
struct Gemm { const bf16_t* A; const bf16_t* Bt; int M, N, K; };
struct StaticOrder {
    int nM, nN, nwg, G, c;
    __device__ void init(int M, int N, int G_, int c_) { nM = M / BM; nN = N / BM; nwg = nM * nN; G = G_; c = c_; }
    __device__ bool next(int i, Unit& u) const {
        const long L = (long)i * G + c; if (L >= nwg) return false;
        int wgid = (int)L; { const int q = nwg / NXCD, r = nwg % NXCD, xcd = wgid % NXCD, off = wgid / NXCD; wgid = (xcd < r ? xcd * (q + 1) : r * (q + 1) + (xcd - r) * q) + off; }
        const int nig = WGM * nN, gid = wgid / nig, fm = gid * WGM, gsz = (nM - fm) < WGM ? (nM - fm) : WGM;
        u.pm = fm + ((wgid % nig) % gsz); u.pn = (wgid % nig) / gsz; return true;
    }
};
struct EpiP {
    static constexpr bool PERM = true;
    bf16_t* O; int ldc;
    __device__ __forceinline__ void operator()(const f32x4 (&acc)[2][2][4][2], const Unit& u, int wr, int wc, int fr, int fq) const {
        const int row0 = u.pm * BM + wr * 64 + fr, col0 = u.pn * BM + wc * 32 + 8 * fq;
        asm volatile("s_nop 15\n\ts_nop 15" ::: "memory");
#pragma unroll
        for (int ai = 0; ai < 2; ++ai)
#pragma unroll
            for (int m = 0; m < 4; ++m) { bf16_t* rowp = O + (size_t)(row0 + ai * HALF + m * 16) * ldc + col0;
#pragma unroll
                for (int bj = 0; bj < 2; ++bj) { const f32x4 v0 = acc[ai][bj][m][0], v1 = acc[ai][bj][m][1];
                    u32x4 w; w.x = pk2(v0[0], v0[1]); w.y = pk2(v0[2], v0[3]); w.z = pk2(v1[0], v1[1]); w.w = pk2(v1[2], v1[3]);
                    *(u32x4*)(rowp + bj * HALF) = w; } }
    }
};
struct EpiRes {
    static constexpr bool PERM = true;
    const float* Xin; float* Xout; const float* gate;
    const float* stats; const float* lw; const float* lb;
    __device__ __forceinline__ void operator()(const f32x4 (&acc)[2][2][4][2], const Unit& u, int wr, int wc, int fr, int fq) const {
        typedef float f32x2_t __attribute__((ext_vector_type(2)));
        const int row0 = u.pm * BM + wr * 64 + fr, col0 = u.pn * BM + wc * 32 + 8 * fq;
        const float* gp = gate + (size_t)((u.pm * BM) >> 11) * 6144 + col0;
        f32x2_t st[2][4];
#pragma unroll
        for (int ai = 0; ai < 2; ++ai)
#pragma unroll
            for (int m = 0; m < 4; ++m) st[ai][m] = stats ? *(const f32x2_t*)(stats + 2 * (row0 + ai * HALF + m * 16)) : (f32x2_t){0.f, 1.f};
#pragma unroll
        for (int bj = 0; bj < 2; ++bj) { const int co = col0 + bj * HALF;
            const f32x4 g0 = *(const f32x4*)(gp + bj * HALF), g1 = *(const f32x4*)(gp + bj * HALF + 4);
            f32x4 w0 = {1.f, 1.f, 1.f, 1.f}, w1 = w0, b0 = {0.f, 0.f, 0.f, 0.f}, b1 = b0;
            if (stats) { w0 = *(const f32x4*)(lw + co); w1 = *(const f32x4*)(lw + co + 4); b0 = *(const f32x4*)(lb + co); b1 = *(const f32x4*)(lb + co + 4); }
#pragma unroll
            for (int ai = 0; ai < 2; ++ai) {
                f32x4 xa[4], xb[4];
#pragma unroll
                for (int m = 0; m < 4; ++m) { const float* xp = Xin + (size_t)(row0 + ai * HALF + m * 16) * D + co; xa[m] = *(const f32x4*)xp; xb[m] = *(const f32x4*)(xp + 4); }
#pragma unroll
                for (int m = 0; m < 4; ++m) { float* op = Xout + (size_t)(row0 + ai * HALF + m * 16) * D + co;
                    f32x4 x0 = xa[m], x1 = xb[m];
                    if (stats) { x0 = (x0 - st[ai][m].x) * st[ai][m].y * w0 + b0; x1 = (x1 - st[ai][m].x) * st[ai][m].y * w1 + b1; }
                    *(f32x4*)op = x0 * ALPHA + g0 * acc[ai][bj][m][0]; *(f32x4*)(op + 4) = x1 * ALPHA + g1 * acc[ai][bj][m][1]; } } }
    }
};
struct EpiSwiglu {
    static constexpr bool PERM = true;
    bf16_t* G;
    __device__ __forceinline__ void operator()(const f32x4 (&acc)[2][2][4][2], const Unit& u, int wr, int wc, int fr, int fq) const {
        const int row0 = u.pm * BM + wr * 64 + fr, col0 = u.pn * HALF + wc * 32 + 8 * fq;
#pragma unroll
        for (int ai = 0; ai < 2; ++ai)
#pragma unroll
            for (int m = 0; m < 4; ++m) { bf16_t* rowp = G + (size_t)(row0 + ai * HALF + m * 16) * DFF + col0;
                f32x4 o[2];
#pragma unroll
                for (int n = 0; n < 2; ++n)
#pragma unroll
                    for (int j = 0; j < 4; ++j) { const float g = acc[ai][0][m][n][j]; o[n][j] = siluf_(g) * acc[ai][1][m][n][j]; }
                u32x4 w; w.x = pk2(o[0][0], o[0][1]); w.y = pk2(o[0][2], o[0][3]); w.z = pk2(o[1][0], o[1][1]); w.w = pk2(o[1][2], o[1][3]);
                *(u32x4*)rowp = w; }
    }
};

template <class Epi, bool ALIGN_EPI = true, bool SP2 = true>
__device__ __forceinline__ void gemm_phase(LAS unsigned char* lds, const Gemm g, const StaticOrder& S, const Epi& E, const int wave_s) {
    int lane_ = lane_id(); asm volatile("" : "+v"(lane_));
    const int wid = wave_s, lane = lane_, tid = wid * 64 + lane, wr = wid >> 2, wc = wid & 3, fr = lane & 15, fq = lane >> 4;
    const int K = g.K, nt = K / BK;
    unsigned voffA[2], voffB[2];
#pragma unroll
    for (int i = 0; i < 2; ++i) { int R, C; stage_rc(tid * 16 + i * 8192, R, C); const int Rb = Epi::PERM ? ((R & ~31) + perm32(R & 31)) : R;
        voffA[i] = (unsigned)(R * K + C) * 2u; voffB[i] = (unsigned)(Rb * K + C) * 2u; }
    const size_t kstep = (size_t)(BK * 2);
    const size_t hstep = (size_t)HALF * K * 2;
    const size_t tstep = 2 * hstep;
    const unsigned ldsw = (unsigned)wid * 1024u;
    const int aoff = lds_byte(wr * 64 + fr, fq * 8), boff = lds_byte(wc * 32 + fr, fq * 8);
#define PG8_SA(b, h) (((b) * 2 + (h)) * HTB)
#define PG8_SB(b, h) ((4 + (b) * 2 + (h)) * HTB)
#define PG8_STAGE(bufoff, gbase, voff) do { _Pragma("unroll") for (int _i = 0; _i < 2; ++_i) \
        __builtin_amdgcn_global_load_lds((const unsigned*)((const char*)(gbase) + (voff)[_i]), (LAS unsigned*)(lds + (bufoff) + ldsw + _i * 8192), 16, 0, 0); } while (0)
#define PG8_LDA(dst, b, h) do { _Pragma("unroll") for (int m = 0; m < 4; ++m) _Pragma("unroll") for (int k = 0; k < 2; ++k) dst[m][k] = *(const LAS bf16x8*)(lds + PG8_SA(b, h) + aoff + m * 2048 + k * 1024); } while (0)
#define PG8_LDB(dst, b, h) do { _Pragma("unroll") for (int n = 0; n < 2; ++n) _Pragma("unroll") for (int k = 0; k < 2; ++k) dst[n][k] = *(const LAS bf16x8*)(lds + PG8_SB(b, h) + boff + n * 2048 + k * 1024); } while (0)
#define PG8_MMA(ai, bj, At, Bt) do { __builtin_amdgcn_s_setprio(1); _Pragma("unroll") for (int m = 0; m < 4; ++m) _Pragma("unroll") for (int n = 0; n < 2; ++n) _Pragma("unroll") for (int k = 0; k < 2; ++k) \
        acc[ai][bj][m][n] = __builtin_amdgcn_mfma_f32_16x16x32_bf16(Bt[n][k], At[m][k], acc[ai][bj][m][n], 0, 0, 0); __builtin_amdgcn_s_setprio(0); } while (0)
#define PG8_WAIT_V(n) asm volatile("s_waitcnt vmcnt(" #n ")" ::: "memory")
#define PG8_WAIT_L(n) asm volatile("s_waitcnt lgkmcnt(" #n ")" ::: "memory")
#define PG8_BAR __builtin_amdgcn_s_barrier()
#define PG8_SCHED __builtin_amdgcn_sched_barrier(0)
    Unit cur, nxt; int ui = 0;
    if (!S.next(0, cur)) return;
    f32x4 acc[2][2][4][2];
#pragma unroll
    for (int a = 0; a < 2; ++a)
#pragma unroll
        for (int b = 0; b < 2; ++b)
#pragma unroll
            for (int m = 0; m < 4; ++m)
#pragma unroll
                for (int n = 0; n < 2; ++n) acc[a][b][m][n] = (f32x4){0.f, 0.f, 0.f, 0.f};
    bf16x8 At[4][2], B0[2][2], B1[2][2];
    const char* cA = (const char*)g.A + (size_t)cur.pm * tstep; const char* cB = (const char*)g.Bt + (size_t)cur.pn * tstep;
    if constexpr (SP2) {
        PG8_STAGE(PG8_SB(0, 0), cB, voffB); PG8_STAGE(PG8_SB(0, 1), cB + hstep, voffB); PG8_STAGE(PG8_SA(0, 0), cA, voffA); PG8_STAGE(PG8_SA(0, 1), cA + hstep, voffA);
        if (wr == 1) PG8_BAR;
        PG8_WAIT_V(2); PG8_BAR;
        PG8_STAGE(PG8_SB(1, 0), cB + kstep, voffB); PG8_STAGE(PG8_SA(1, 0), cA + kstep, voffA); PG8_STAGE(PG8_SB(1, 1), cB + hstep + kstep, voffB);
        PG8_WAIT_V(6); PG8_BAR;
    } else {
    PG8_STAGE(PG8_SB(0, 0), cB, voffB); PG8_STAGE(PG8_SA(0, 0), cA, voffA); PG8_STAGE(PG8_SB(0, 1), cB + hstep, voffB); PG8_STAGE(PG8_SA(0, 1), cA + hstep, voffA);
    if (wr == 1) PG8_BAR;
    PG8_WAIT_V(4); PG8_BAR;
    PG8_STAGE(PG8_SB(1, 0), cB + kstep, voffB); PG8_STAGE(PG8_SA(1, 0), cA + kstep, voffA); PG8_STAGE(PG8_SB(1, 1), cB + hstep + kstep, voffB);
    PG8_WAIT_V(6); PG8_BAR;
    }
    for (;;) {
        const bool has_next = S.next(ui + 1, nxt);
        const char* nA = has_next ? (const char*)g.A + (size_t)nxt.pm * tstep : cA; const char* nB = has_next ? (const char*)g.Bt + (size_t)nxt.pn * tstep : cB;
        for (int t = 0; t < nt; t += 2) {
            const bool last = (t == nt - 2);
            const char* a1 = cA + (size_t)(t + 1) * kstep;
            const char* a2 = last ? nA : cA + (size_t)(t + 2) * kstep; const char* b2 = last ? nB : cB + (size_t)(t + 2) * kstep;
            const char* a3 = a2 + kstep; const char* b3 = b2 + kstep;
            if constexpr (SP2) {
            PG8_LDB(B0, 0, 0); PG8_LDB(B1, 0, 1); PG8_SCHED; PG8_LDA(At, 0, 0); PG8_STAGE(PG8_SA(1, 1), a1 + hstep, voffA);
            PG8_WAIT_V(8); PG8_WAIT_L(0); PG8_BAR; PG8_MMA(0, 0, At, B0); PG8_MMA(0, 1, At, B1); PG8_BAR; PG8_SCHED;
            PG8_LDA(At, 0, 1); PG8_STAGE(PG8_SB(0, 0), b2, voffB); PG8_STAGE(PG8_SB(0, 1), b2 + hstep, voffB); PG8_STAGE(PG8_SA(0, 0), a2, voffA);
            PG8_WAIT_V(8); PG8_WAIT_L(0); PG8_BAR; PG8_MMA(1, 0, At, B0); PG8_MMA(1, 1, At, B1); PG8_BAR; PG8_SCHED;
            PG8_LDB(B0, 1, 0); PG8_LDB(B1, 1, 1); PG8_SCHED; PG8_LDA(At, 1, 0); PG8_STAGE(PG8_SA(0, 1), a2 + hstep, voffA);
            PG8_WAIT_V(8); PG8_WAIT_L(0); PG8_BAR; PG8_MMA(0, 0, At, B0); PG8_MMA(0, 1, At, B1); PG8_BAR; PG8_SCHED;
            PG8_LDA(At, 1, 1); PG8_STAGE(PG8_SB(1, 0), b3, voffB); PG8_STAGE(PG8_SB(1, 1), b3 + hstep, voffB); PG8_STAGE(PG8_SA(1, 0), a3, voffA);
            PG8_WAIT_V(8); PG8_WAIT_L(0); PG8_BAR; PG8_MMA(1, 0, At, B0); PG8_MMA(1, 1, At, B1); PG8_BAR; PG8_SCHED;
            } else {
            PG8_LDB(B0, 0, 0); PG8_SCHED; PG8_LDA(At, 0, 0); PG8_STAGE(PG8_SA(1, 1), a1 + hstep, voffA);
            PG8_WAIT_L(8); PG8_BAR; PG8_WAIT_L(0); PG8_MMA(0, 0, At, B0); PG8_BAR; PG8_SCHED;
            PG8_LDB(B1, 0, 1); PG8_STAGE(PG8_SB(0, 0), b2, voffB);
            PG8_BAR; PG8_WAIT_L(0); PG8_MMA(0, 1, At, B1); PG8_BAR;
            PG8_LDA(At, 0, 1); PG8_STAGE(PG8_SA(0, 0), a2, voffA);
            PG8_BAR; PG8_WAIT_L(0); PG8_MMA(1, 0, At, B0); PG8_BAR; PG8_SCHED;
            PG8_STAGE(PG8_SB(0, 1), b2 + hstep, voffB);
            PG8_WAIT_V(6); PG8_BAR; PG8_MMA(1, 1, At, B1); PG8_BAR;
            PG8_LDB(B0, 1, 0); PG8_SCHED; PG8_LDA(At, 1, 0); PG8_STAGE(PG8_SA(0, 1), a2 + hstep, voffA);
            PG8_WAIT_L(8); PG8_BAR; PG8_WAIT_L(0); PG8_MMA(0, 0, At, B0); PG8_BAR; PG8_SCHED;
            PG8_LDB(B1, 1, 1); PG8_STAGE(PG8_SB(1, 0), b3, voffB);
            PG8_BAR; PG8_WAIT_L(0); PG8_MMA(0, 1, At, B1); PG8_BAR;
            PG8_LDA(At, 1, 1); PG8_STAGE(PG8_SA(1, 0), a3, voffA);
            PG8_BAR; PG8_WAIT_L(0); PG8_MMA(1, 0, At, B0); PG8_BAR; PG8_SCHED;
            PG8_STAGE(PG8_SB(1, 1), b3 + hstep, voffB);
            PG8_WAIT_V(6); PG8_BAR; PG8_MMA(1, 1, At, B1); PG8_BAR;
            }
        }
        if constexpr (ALIGN_EPI) { if (wr == 0) PG8_BAR; }
        E(acc, cur, wr, wc, fr, fq);
        if (!has_next) break;
#pragma unroll
        for (int a = 0; a < 2; ++a)
#pragma unroll
            for (int b = 0; b < 2; ++b)
#pragma unroll
                for (int m = 0; m < 4; ++m)
#pragma unroll
                    for (int n = 0; n < 2; ++n) acc[a][b][m][n] = (f32x4){0.f, 0.f, 0.f, 0.f};
        cur = nxt; cA = nA; cB = nB; ++ui;
        if constexpr (ALIGN_EPI) { if (wr == 1) PG8_BAR; }
    }
    PG8_WAIT_V(0);
    if constexpr (!ALIGN_EPI) { if (wr == 0) PG8_BAR; }
    PG8_BAR;
#undef PG8_SA
#undef PG8_SB
#undef PG8_STAGE
#undef PG8_LDA
#undef PG8_LDB
#undef PG8_MMA
#undef PG8_WAIT_V
#undef PG8_WAIT_L
#undef PG8_BAR
#undef PG8_SCHED
}
}

__device__ __forceinline__ int colmap(int mode, int n) {
    if (mode == 0) return n < INW ? n : -1;
    if (mode == 2) return ((n >> 7) & 1) * DFF + (n >> 8) * 128 + (n & 127);
    return n;
}
__device__ __forceinline__ void transpose_tile(const float* src, int Nsrc, bf16_t* dst, int K, int n0, int k0, int mode, LAS float* scr, int tid) {
    const int c = tid & 63, r0 = tid >> 6;
    const int sc = colmap(mode, n0 + c);
#pragma unroll
    for (int i = 0; i < 8; ++i) { const int r = r0 + 8 * i; scr[r * 65 + c] = sc >= 0 ? src[(size_t)(k0 + r) * Nsrc + sc] : 0.f; }
    __syncthreads();
    const int kp = (tid & 31) * 2;
#pragma unroll
    for (int i = 0; i < 4; ++i) { const int r = (tid >> 5) + 16 * i;
        *(unsigned*)(dst + (size_t)(n0 + r) * K + k0 + kp) = pk2(scr[kp * 65 + r], scr[(kp + 1) * 65 + r]); }
    __syncthreads();
}
__device__ __forceinline__ void ada_unit(const float* c, const float* w_ada, const float* b_ada, float* mod, int unit, LAS float* lds, int tid_in) {
    const int tid = lv(tid_in);
    const int l = unit / 96, cb = unit % 96;
    for (int i = tid; i < NB * D; i += 512) { const int b = i >> 10, k = i & 1023; lds[k * 32 + b] = siluf_(c[i]); }
    __syncthreads();
    const int col = tid & 63, kg = tid >> 6;
    float acc[32];
#pragma unroll
    for (int b = 0; b < 32; ++b) acc[b] = 0.f;
    { const __amdgpu_buffer_rsrc_t rw = __builtin_amdgcn_make_buffer_rsrc((void*)w_ada, 0, 0x7fffffff, 0x00020000);
      const int kgs = __builtin_amdgcn_readfirstlane(kg), vo = (cb * 64 + col) * 4;
      for (int k0 = kgs * 128; k0 < kgs * 128 + 128; k0 += 8) {
        float w[8];
#pragma unroll
        for (int u = 0; u < 8; ++u) w[u] = __builtin_bit_cast(float, __builtin_amdgcn_raw_buffer_load_b32(rw, vo, ((l * D + k0 + u) * 6144) * 4, 0));
#pragma unroll
        for (int u = 0; u < 8; ++u) {
#pragma unroll
            for (int b4 = 0; b4 < 8; ++b4) { const f32x4 cv = *(const LAS f32x4*)(lds + (k0 + u) * 32 + b4 * 4);
#pragma unroll
                for (int j = 0; j < 4; ++j) acc[b4 * 4 + j] += cv[j] * w[u]; } }
      } }
    __syncthreads();
#pragma unroll
    for (int b = 0; b < 32; ++b) lds[(kg * 32 + b) * 64 + col] = acc[b];
    __syncthreads();
    for (int o = tid; o < 2048; o += 512) { const int b = o >> 6, cc = o & 63; float s = 0.f;
#pragma unroll
        for (int q = 0; q < 8; ++q) s += lds[(q * 32 + b) * 64 + cc];
        ((float*)(argws() + WS_MOD))[(size_t)(l * 32 + b) * 6144 + cb * 64 + cc] = s + argf(4)[l * 6144 + cb * 64 + cc]; }
    __syncthreads();
}
__device__ __forceinline__ void modulate_phase(const float* X, const float* sh, const float* sc, bf16_t* H, int gtid, int gthreads) {
    for (int idx = gtid; idx < T * 128; idx += gthreads) {
        const int row = idx >> 7, c = (idx & 127) * 8, b = row >> 11;
        const f32x4 x0 = *(const f32x4*)(X + (size_t)row * D + c), x1 = *(const f32x4*)(X + (size_t)row * D + c + 4);
        const f32x4 s0 = *(const f32x4*)(sc + b * 6144 + c), s1 = *(const f32x4*)(sc + b * 6144 + c + 4);
        const f32x4 h0 = *(const f32x4*)(sh + b * 6144 + c), h1 = *(const f32x4*)(sh + b * 6144 + c + 4);
        const f32x4 v0 = x0 * (s0 + 1.f) + h0, v1 = x1 * (s1 + 1.f) + h1;
        u32x4 w; w.x = pk2(v0[0], v0[1]); w.y = pk2(v0[2], v0[3]); w.z = pk2(v1[0], v1[1]); w.w = pk2(v1[2], v1[3]);
        *(u32x4*)(H + (size_t)row * D + c) = w;
    }
}
__device__ __forceinline__ void ln_phase(const float* Z, float* Xo, bf16_t* H, float* stats, const float* w, const float* bv, const float* sh, const float* sc, int gw, int ngw, int lane) {
    const int rpw = (T + ngw - 1) / ngw, rbeg = gw * rpw, rend = (rbeg + rpw < T) ? (rbeg + rpw) : T;
    f32x4 wv[4], bb[4], s4[4], h4[4];
#pragma unroll
    for (int j = 0; j < 4; ++j) { const int c = 4 * lane + 256 * j; wv[j] = *(const f32x4*)(w + c); bb[j] = *(const f32x4*)(bv + c); s4[j] = (f32x4){0.f, 0.f, 0.f, 0.f}; h4[j] = s4[j]; }
    int bcur = -1;
    for (int row0 = rbeg; row0 < rend; row0 += 4) {
        f32x4 v[4][4];
#pragma unroll
        for (int u = 0; u < 4; ++u) { const int row = row0 + u;
            if (row < rend) { const float* zr = Z + (size_t)row * D + 4 * lane;
#pragma unroll
                for (int j = 0; j < 4; ++j) v[u][j] = *(const f32x4*)(zr + 256 * j); } }
#pragma unroll
        for (int u = 0; u < 4; ++u) { const int row = row0 + u;
            if (row < rend) { const int b = row >> 11;
                if (H && b != bcur) { bcur = b;
#pragma unroll
                    for (int j = 0; j < 4; ++j) { const int c = 4 * lane + 256 * j; s4[j] = *(const f32x4*)(sc + b * 6144 + c) + 1.f; h4[j] = *(const f32x4*)(sh + b * 6144 + c); } }
                float s = 0.f;
#pragma unroll
                for (int j = 0; j < 4; ++j) s += (v[u][j][0] + v[u][j][1]) + (v[u][j][2] + v[u][j][3]);
                const float mean = wave_sum(s) * (1.f / D); float s2 = 0.f;
#pragma unroll
                for (int j = 0; j < 4; ++j) { v[u][j] = v[u][j] - mean; s2 += (v[u][j][0] * v[u][j][0] + v[u][j][1] * v[u][j][1]) + (v[u][j][2] * v[u][j][2] + v[u][j][3] * v[u][j][3]); }
                const float rstd = rsqrtf(wave_sum(s2) * (1.f / D) + EPS);
                if (stats && lane == 0) { stats[2 * row] = mean; stats[2 * row + 1] = rstd; }
#pragma unroll
                for (int j = 0; j < 4; ++j) { const int c = 4 * lane + 256 * j;
                    const f32x4 xo = v[u][j] * rstd * wv[j] + bb[j];
                    if (Xo) *(f32x4*)(Xo + (size_t)row * D + c) = xo;
                    if (H) { const f32x4 hv = xo * s4[j] + h4[j];
                        u32x2 o; o.x = pk2(hv[0], hv[1]); o.y = pk2(hv[2], hv[3]);
                        *(u32x2*)(H + (size_t)row * D + c) = o; } } } }
    }
}
__device__ __forceinline__ void ssd_norm_phase(bf16_t* Y, const float* nw, int gw, int ngw, int lane) {
    const f32x4 wv = *(const f32x4*)(nw + 4 * lane);
    for (int row0 = gw; row0 < T; row0 += 8 * ngw) {
        u32x2 r[8];
#pragma unroll
        for (int u = 0; u < 8; ++u) { const int row = row0 + u * ngw; if (row < T) r[u] = *(const u32x2*)(Y + (size_t)row * D + 4 * lane); }
#pragma unroll
        for (int u = 0; u < 8; ++u) { const int row = row0 + u * ngw;
            if (row < T) {
                const float a0 = __uint_as_float(r[u].x << 16), a1 = __uint_as_float(r[u].x & 0xffff0000u), a2 = __uint_as_float(r[u].y << 16), a3 = __uint_as_float(r[u].y & 0xffff0000u);
                const float ss = wave_sum((a0 * a0 + a1 * a1) + (a2 * a2 + a3 * a3));
                const float rstd = rsqrtf(ss * (1.f / 256.f) + EPS);
                u32x2 o; o.x = pk2(a0 * rstd * wv[0], a1 * rstd * wv[1]); o.y = pk2(a2 * rstd * wv[2], a3 * rstd * wv[3]);
                *(u32x2*)(Y + (size_t)row * D + 4 * lane) = o; } }
    }
}


constexpr int TC = 64, NCH = SEQ / TC;
typedef __amdgpu_buffer_rsrc_t rsrc_t;
__device__ __forceinline__ rsrc_t mk_rsrc(const void* p) { return __builtin_amdgcn_make_buffer_rsrc((void*)p, 0, 0x7fffffff, 0x00020000); }
__device__ __forceinline__ unsigned bl16(rsrc_t r, int voff_bytes, int soff_bytes) { return (unsigned)__builtin_amdgcn_raw_buffer_load_b16(r, voff_bytes, soff_bytes, 0); }
__device__ __forceinline__ float bfu2f(unsigned v) { return __uint_as_float(v << 16); }
__device__ __forceinline__ void bs16(rsrc_t r, bf16_t v, int voff_bytes, int soff_bytes) { __builtin_amdgcn_raw_buffer_store_b16(v, r, voff_bytes, soff_bytes, 0); }

__device__ __forceinline__ void gla_job(const bf16_t* P, bf16_t* Y, int l, int b, int h, LAS float* lds, int wave_s) {
    const int tid = wave_s * 64 + lv(lane_id());
    LAS float* GL = lds + 20480; LAS float* Yl = lds + 21504;
    const int wave = tid >> 6, lane = tid & 63, k0 = (lane & 3) * 8, pp = (wave & 3) * 16 + (lane >> 2);
    const int ki = tid & 31, t2 = tid & 255;
    float wg[16];
#pragma unroll
    for (int j = 0; j < 16; ++j) wg[j] = argf(20)[l * 2048 + j * 128 + h * 32 + ki];
    const float bgv = argf(21)[l * 128 + h * 32 + ki];
    const float nw = argf(22)[l * 256 + h * 64 + lane];
    float S[8];
#pragma unroll
    for (int i = 0; i < 8; ++i) S[i] = 0.f;
    unsigned gln[4], qn[8], kn[8], vn[16], rn[16], rc[16];
    const rsrc_t rs = mk_rsrc(P);
    const int rb2 = b * SEQ * INP * 2;
    const rsrc_t ry = mk_rsrc(Y); const int yb2 = b * SEQ * D * 2, voY = ((wave & 3) * D + 768 + h * 64 + lane) * 2;
    const int voG = ((t2 >> 4) * INP + C_GLA_GL + (t2 & 15)) * 2, voQ = ((t2 >> 5) * INP + h * 32 + ki) * 2, voV = ((wave & 3) * INP + h * 64 + lane) * 2;
#define GLA_LOAD(t0_) do { const int so__ = rb2 + (t0_) * INP * 2; \
        _Pragma("unroll") for (int i = 0; i < 4; ++i) gln[i] = bl16(rs, voG, so__ + 16 * i * INP * 2); \
        _Pragma("unroll") for (int i = 0; i < 8; ++i) { const int s2 = so__ + 8 * i * INP * 2; qn[i] = bl16(rs, voQ, s2 + C_GLA_Q * 2); kn[i] = bl16(rs, voQ, s2 + C_GLA_K * 2); } \
        _Pragma("unroll") for (int i = 0; i < 16; ++i) vn[i] = bl16(rs, voV, so__ + (4 * i * INP + C_GLA_V) * 2); } while (0)
#define GLA_LOADR(t0_) do { const int so__ = rb2 + (t0_) * INP * 2; _Pragma("unroll") for (int i = 0; i < 16; ++i) rn[i] = bl16(rs, voV, so__ + (4 * i * INP + C_GLA_R) * 2); } while (0)
#define GLA_STAGE(set_) do { LAS float* B__ = lds + (set_) * 10240; \
        _Pragma("unroll") for (int i = 0; i < 4; ++i) GL[((t2 >> 4) + 16 * i) * 16 + (t2 & 15)] = bfu2f(gln[i]); \
        _Pragma("unroll") for (int i = 0; i < 8; ++i) { const int t = (t2 >> 5) + 8 * i; B__[t * 32 + ki] = bfu2f(qn[i]) * 0.17677669529663687f; B__[2048 + t * 32 + ki] = bfu2f(kn[i]); } \
        _Pragma("unroll") for (int i = 0; i < 16; ++i) { const int t = (wave & 3) + 4 * i; B__[6144 + t * 64 + lane] = bfu2f(vn[i]); } } while (0)
#define GLA_FINAL(cprev_) do { const int cp__ = (cprev_); const LAS float* Yp__ = Yl + (cp__ & 1) * 4096; \
        _Pragma("unroll") for (int i = 0; i < 16; ++i) { const int t = (wave & 3) + 4 * i; const float y = Yp__[t * 64 + lane]; \
            const float ms = wave_sum(y * y) * (1.f / 64.f); \
            bs16(ry, f2bf(y * rsqrtf(ms + EPS) * nw * siluf_(bfu2f(rc[i]))), voY, yb2 + (cp__ * TC + 4 * i) * D * 2); } } while (0)
    if (wave_s >= 4) { GLA_LOAD(0); GLA_LOADR(0); GLA_STAGE(0); GLA_LOAD(TC); }
    __syncthreads();
    for (int c = 0; c < NCH; ++c) {
        const int t0 = c * TC;
        LAS float* Bs = lds + (c & 1) * 10240;
#pragma unroll
        for (int i = 0; i < 4; ++i) { const int t = (tid >> 5) + 16 * i; float s = bgv;
#pragma unroll
            for (int j = 0; j < 16; ++j) s += GL[t * 16 + j] * wg[j];
            const float ls = fminf(s, 0.f) - __logf(1.f + __expf(-fabsf(s)));
            Bs[4096 + t * 32 + ki] = __expf(ls * (1.f / 16.f)); }
        __syncthreads();
        if (wave_s < 4) {
            LAS float* ydst = (lane & 3) == 0 ? (Yl + (c & 1) * 4096 + pp) : (lds + (LDS_XB + 256) / 4 + lane); const int ystride = (lane & 3) == 0 ? 64 : 0;
            f32x4 a0_[2], k0_[2], q0_[2], a1_[2], k1_[2], q1_[2]; float v0_, v1_;
#define GLA_LD(t_, aq, kq, qq, vq) do { const int tt_ = (t_); vq = Bs[6144 + tt_ * 64 + pp]; \
            _Pragma("unroll") for (int u = 0; u < 2; ++u) { aq[u] = *(const LAS f32x4*)(Bs + 4096 + tt_ * 32 + k0 + 4 * u); kq[u] = *(const LAS f32x4*)(Bs + 2048 + tt_ * 32 + k0 + 4 * u); qq[u] = *(const LAS f32x4*)(Bs + tt_ * 32 + k0 + 4 * u); } } while (0)
#define GLA_STEP(t_, aq, kq, qq, vq) do { float y = 0.f; \
            _Pragma("unroll") for (int u = 0; u < 2; ++u) _Pragma("unroll") for (int j = 0; j < 4; ++j) { S[4 * u + j] = aq[u][j] * S[4 * u + j] + kq[u][j] * vq; y += qq[u][j] * S[4 * u + j]; } \
            y += dpp_f(y, 0xB1); y += dpp_f(y, 0x4E); ydst[(t_) * ystride] = y; } while (0)
            GLA_LD(0, a0_, k0_, q0_, v0_);
            for (int t = 0; t < TC; t += 2) {
                GLA_LD(t + 1, a1_, k1_, q1_, v1_);
                GLA_STEP(t, a0_, k0_, q0_, v0_);
                GLA_LD(t + 2 < TC ? t + 2 : t + 1, a0_, k0_, q0_, v0_);
                GLA_STEP(t + 1, a1_, k1_, q1_, v1_);
            }
#undef GLA_LD
#undef GLA_STEP
        } else {
            if (c > 0) GLA_FINAL(c - 1);
#pragma unroll
            for (int i = 0; i < 16; ++i) rc[i] = rn[i];
            if (c + 1 < NCH) { GLA_LOADR(t0 + TC); GLA_STAGE((c + 1) & 1); if (c + 2 < NCH) GLA_LOAD(t0 + 2 * TC); }
        }
        __syncthreads();
    }
    if (wave_s >= 4) GLA_FINAL(NCH - 1);
    __syncthreads();
#undef GLA_LOAD
#undef GLA_LOADR
#undef GLA_STAGE
#undef GLA_FINAL
}

__device__ __forceinline__ void lru_job(const bf16_t* P, bf16_t* Y, int l, int b, int kb, LAS float* lds, int wave_s) {
    const int tid = wave_s * 64 + lv(lane_id());
    LAS float* XC = lds; LAS float* Aa = lds + 4096; LAS float* Uu = lds + 8192; LAS float* Hh = lds + 12288;
    const int j = tid & 63, tg = tid >> 6, ch = kb * 64 + j;
    typedef float f32x2_t __attribute__((ext_vector_type(2)));
    f32x2_t wax[64];
    { const float* wap = argf(15) + l * 16384; const float* wxp = argf(17) + l * 16384;
#pragma unroll
      for (int i = 0; i < 64; ++i) { wax[i].x = wap[(kb * 64 + i) * 64 + j]; wax[i].y = wxp[(kb * 64 + i) * 64 + j]; } }
    const float ba = argf(16)[l * 256 + ch], bx = argf(18)[l * 256 + ch], spl = softplusf_(-argf(19)[l * 256 + ch]);
    const float* cwp = argf(13) + l * 1024;
    const float cw0 = cwp[ch], cw1 = cwp[256 + ch], cw2 = cwp[512 + ch], cw3 = cwp[768 + ch], cb = argf(14)[l * 256 + ch];
    float hs = 0.f;
    unsigned xn[8][4], gtn[8], gtc[8];
    const rsrc_t rs = mk_rsrc(P);
    const int rb2 = b * SEQ * INP * 2;
    const rsrc_t ry = mk_rsrc(Y); const int yb2 = b * SEQ * D * 2, voY = (tg * D + 512 + ch) * 2;
    const int voX = (tg * INP + ch) * 2;
#define LRU_LOAD(t0_) do { const int t0__ = (t0_); const int so__ = rb2 + t0__ * INP * 2; \
        _Pragma("unroll") for (int i = 0; i < 8; ++i) { gtn[i] = bl16(rs, voX, so__ + (8 * i * INP + C_LRU_G) * 2); \
            _Pragma("unroll") for (int k = 0; k < 4; ++k) { \
                if (t0__ == 0 && i == 0 && k < 3) { const int tt = tg - 3 + k; const unsigned v = bl16(rs, (ch + (tt >= 0 ? tt : 0) * INP) * 2, rb2 + C_LRU_X * 2); xn[i][k] = tt >= 0 ? v : 0u; } \
                else xn[i][k] = bl16(rs, voX, so__ + ((8 * i - 3 + k) * INP + C_LRU_X) * 2); } } } while (0)
    LRU_LOAD(0);
    for (int c = 0; c < NCH; ++c) {
        const int t0 = c * TC;
#pragma unroll
        for (int i = 0; i < 8; ++i) { XC[(tg + 8 * i) * 64 + j] = cw0 * bfu2f(xn[i][0]) + cw1 * bfu2f(xn[i][1]) + cw2 * bfu2f(xn[i][2]) + cw3 * bfu2f(xn[i][3]) + cb; gtc[i] = gtn[i]; }
        __syncthreads();
        if (c + 1 < NCH) LRU_LOAD(t0 + TC);
#pragma unroll 1
        for (int tt = 0; tt < 8; ++tt) { const int t = tg * 8 + tt; f32x2_t dd = {ba, bx};
#pragma unroll
            for (int i4 = 0; i4 < 16; ++i4) { const f32x4 xv = *(const LAS f32x4*)(XC + t * 64 + 4 * i4);
#pragma unroll
                for (int q = 0; q < 4; ++q) { const f32x2_t xb = {xv[q], xv[q]}; dd = __builtin_elementwise_fma(xb, wax[4 * i4 + q], dd); } }
            const float rg = sigmoidf_(dd.x), ig = sigmoidf_(dd.y);
            const float la = -8.f * rg * spl;
            const float av = __expf(la);
            Aa[t * 64 + j] = av;
            Uu[t * 64 + j] = sqrtf(fmaxf(1.f - av * av, 0.f)) * (ig * XC[t * 64 + j]); }
        __syncthreads();
        if (tid < 64) {
            for (int tb = 0; tb < TC; tb += 8) { float av[8], uv[8];
#pragma unroll
                for (int k = 0; k < 8; ++k) { av[k] = Aa[(tb + k) * 64 + j]; uv[k] = Uu[(tb + k) * 64 + j]; }
#pragma unroll
                for (int k = 0; k < 8; ++k) { hs = av[k] * hs + uv[k]; Hh[(tb + k) * 64 + j] = hs; } }
        }
        __syncthreads();
#pragma unroll
        for (int i = 0; i < 8; ++i) { const int t = tg + 8 * i;
            const float gt = bfu2f(gtc[i]);
            const float ge = gt * sigmoidf_(1.5957691216057308f * (gt + 0.044715f * gt * gt * gt));
            bs16(ry, f2bf(Hh[t * 64 + j] * ge), voY, yb2 + (t0 + 8 * i) * D * 2); }
    }
    __syncthreads();
#undef LRU_LOAD
}


__device__ __forceinline__ unsigned pk2_c(float lo, float hi) {
    unsigned a = __float_as_uint(lo), b = __float_as_uint(hi);
    a += 0x7fffu + ((a >> 16) & 1u); b += 0x7fffu + ((b >> 16) & 1u);
    return (a >> 16) | (b & 0xffff0000u);
}
__device__ __forceinline__ bf16x8 mfrag(const LAS bf16_t* base, int ld, int row0, int k0, int r, int q) { return *(const LAS bf16x8*)(base + (row0 + r) * ld + k0 + 8 * q); }
template <int N>
__device__ __forceinline__ void sd_chunk_core(LAS bf16_t* Qs, LAS bf16_t* Ks, LAS bf16_t* ST, LAS bf16_t* KdT, LAS bf16_t* VT, LAS bf16_t* Gs, LAS float* Yl, const LAS float* cum,
                                              f32x4 (&Sacc)[N / 32], int wave, int lane) {
    constexpr int LDN = N + 8, NK = N / 32, NST = N / 32;
    const int r = lane & 15, q = lane >> 4, ti = wave >> 1, half = wave & 1;
    bf16x8 aQ[NK];
#pragma unroll
    for (int k = 0; k < NK; ++k) aQ[k] = mfrag(Qs, LDN, 16 * ti, 32 * k, r, q);
#pragma unroll
    for (int sj = 0; sj < 2; ++sj) { const int si = 2 * half + sj;
        f32x4 acc = {0.f, 0.f, 0.f, 0.f};
        if (si <= ti) {
#pragma unroll
            for (int k = 0; k < NK; ++k) acc = __builtin_amdgcn_mfma_f32_16x16x32_bf16(aQ[k], mfrag(Ks, LDN, 16 * si, 32 * k, r, q), acc, 0, 0, 0);
        }
        const int sc = 16 * si + r; const float cs = cum[sc];
#pragma unroll
        for (int j = 0; j < 4; ++j) { const int t = 16 * ti + 4 * q + j;
            const float v = (si <= ti && sc <= t) ? acc[j] * __expf(cum[t] - cs) : 0.f;
            Gs[t * 72 + sc] = f2bf(v); } }
    f32x4 cB[2];
#pragma unroll
    for (int pj = 0; pj < 2; ++pj) { const int pi = 2 * half + pj; cB[pj] = (f32x4){0.f, 0.f, 0.f, 0.f};
#pragma unroll
        for (int k = 0; k < NK; ++k) cB[pj] = __builtin_amdgcn_mfma_f32_16x16x32_bf16(aQ[k], mfrag(ST, LDN, 16 * pi, 32 * k, r, q), cB[pj], 0, 0, 0); }
    __syncthreads();
    { bf16x8 aG[2];
#pragma unroll
      for (int kk = 0; kk < 2; ++kk) aG[kk] = mfrag(Gs, 72, 16 * ti, 32 * kk, r, q);
#pragma unroll
      for (int pj = 0; pj < 2; ++pj) { const int pi = 2 * half + pj; f32x4 cA = {0.f, 0.f, 0.f, 0.f};
#pragma unroll
          for (int kk = 0; kk < 2; ++kk) cA = __builtin_amdgcn_mfma_f32_16x16x32_bf16(aG[kk], mfrag(VT, 72, 16 * pi, 32 * kk, r, q), cA, 0, 0, 0);
#pragma unroll
          for (int j = 0; j < 4; ++j) { const int t = 16 * ti + 4 * q + j; Yl[t * 64 + 16 * pi + r] = cA[j] + __expf(cum[t]) * cB[pj][j]; } } }
    { const float dL = __expf(cum[63]);
      const int ni = (N == 128) ? wave : (wave >> 1);
      bf16x8 aK[2];
#pragma unroll
      for (int kk = 0; kk < 2; ++kk) aK[kk] = mfrag(KdT, 72, 16 * ni, 32 * kk, r, q);
#pragma unroll
      for (int u = 0; u < NST; ++u) { const int pi = (N == 128) ? u : (2 * half + u);
          Sacc[u] = Sacc[u] * dL;
#pragma unroll
          for (int kk = 0; kk < 2; ++kk) Sacc[u] = __builtin_amdgcn_mfma_f32_16x16x32_bf16(aK[kk], mfrag(VT, 72, 16 * pi, 32 * kk, r, q), Sacc[u], 0, 0, 0);
          u32x2 w; w.x = pk2_c(Sacc[u][0], Sacc[u][1]); w.y = pk2_c(Sacc[u][2], Sacc[u][3]);
          *(LAS u32x2*)(ST + (16 * pi + r) * LDN + 16 * ni + 4 * q) = w; } }
    __syncthreads();
}

__device__ __forceinline__ void ssdm_job(const bf16_t* P, bf16_t* Y, int l, int b, int h, LAS float* lds, int wave_s) {
    const int tid = wave_s * 64 + lv(lane_id());
    const int wave = tid >> 6, lane = tid & 63, g = h >> 1;
    LAS unsigned char* L = (LAS unsigned char*)lds;
    LAS bf16_t* Qs = (LAS bf16_t*)(L); LAS bf16_t* Ks = (LAS bf16_t*)(L + 17408); LAS bf16_t* ST = (LAS bf16_t*)(L + 34816); LAS bf16_t* KdT = (LAS bf16_t*)(L + 52224);
    LAS bf16_t* VT = (LAS bf16_t*)(L + 70656); LAS bf16_t* Gs = (LAS bf16_t*)(L + 79872); LAS float* Yl = (LAS float*)(L + 89088); LAS float* Xs = (LAS float*)(L + 105472);
    LAS bf16_t* Zs = (LAS bf16_t*)(L + 121856); LAS float* cum = (LAS float*)(L + 130048); LAS float* Dt = (LAS float*)(L + 130304);
    int xi = 0;
    if (tid < 64) xi = h * 64 + tid; else if (tid < 192) xi = 256 + g * 128 + (tid - 64); else if (tid < 320) xi = 512 + g * 128 + (tid - 192);
    float cw0 = 0.f, cw1 = 0.f, cw2 = 0.f, cw3 = 0.f, cb = 0.f, r1 = 0.f, r2 = 0.f, r3 = 0.f;
    if (tid < 320) { const float* cwp = argf(6) + l * 4 * 768; cw0 = cwp[xi]; cw1 = cwp[768 + xi]; cw2 = cwp[1536 + xi]; cw3 = cwp[2304 + xi]; cb = argf(7)[l * 768 + xi]; }
    const float dsk = argf(10)[l * 4 + h];
    f32x4 Sacc[4];
#pragma unroll
    for (int u = 0; u < 4; ++u) Sacc[u] = (f32x4){0.f, 0.f, 0.f, 0.f};
    for (int i = tid; i < 64 * 136 / 2; i += 512) ((LAS unsigned*)ST)[i] = 0u;
    unsigned rn[TC];
    const rsrc_t rs = mk_rsrc(P);
    const int rb2 = b * SEQ * INP * 2;
    const rsrc_t ry = mk_rsrc(Y); const int yb2 = b * SEQ * D * 2, voY = (wave * D + h * 64 + lane) * 2;
    const int zhalf = (tid >> 6) & 1;
    const int voA = tid < 320 ? (C_SSD_XBC + xi) * 2 : (tid < 384 ? ((tid - 320) * INP + C_SSD_DT + h) * 2 : (zhalf * 32 * INP + C_SSD_Z + h * 64 + lane) * 2);
#define SSD_LOAD(t0_) do { const int so__ = rb2 + (t0_) * INP * 2; \
        if (tid < 320) { _Pragma("unroll") for (int t = 0; t < TC; ++t) rn[t] = bl16(rs, voA, so__ + t * INP * 2); } \
        else if (tid < 384) rn[0] = bl16(rs, voA, so__); \
        else { _Pragma("unroll") for (int t = 0; t < 32; ++t) rn[t] = bl16(rs, voA, so__ + t * INP * 2); } } while (0)
    SSD_LOAD(0);
    for (int c = 0; c < NCH; ++c) {
        const int t0 = c * TC;
        if (tid < 64) {
#pragma unroll
            for (int t = 0; t < TC; ++t) { const float r0 = bfu2f(rn[t]); Xs[t * 64 + tid] = siluf_(cw0 * r3 + cw1 * r2 + cw2 * r1 + cw3 * r0 + cb); r3 = r2; r2 = r1; r1 = r0;
                if ((t & 7) == 7) __builtin_amdgcn_sched_barrier(0); }
        } else if (tid < 320) {
            LAS bf16_t* dst = tid < 192 ? (Ks + (tid - 64)) : (Qs + (tid - 192));
#pragma unroll
            for (int t = 0; t < TC; ++t) { const float r0 = bfu2f(rn[t]); dst[t * 136] = f2bf(siluf_(cw0 * r3 + cw1 * r2 + cw2 * r1 + cw3 * r0 + cb)); r3 = r2; r2 = r1; r1 = r0;
                if ((t & 7) == 7) __builtin_amdgcn_sched_barrier(0); }
        } else if (tid < 384) {
            const int ln = lv(lane);
            const float dtv = softplusf_(bfu2f(rn[0]) + argf(8)[l * 4 + h]);
            float cs = -expf(argf(9)[l * 4 + h]) * dtv;
#pragma unroll
            for (int d = 1; d < 64; d <<= 1) { const float o = __shfl_up(cs, d); if (ln >= d) cs += o; }
            Dt[ln] = dtv; cum[ln] = cs;
        } else {
#pragma unroll
            for (int t = 0; t < 32; ++t) Zs[(zhalf * 32 + t) * 64 + lane] = (bf16_t)rn[t];
        }
        __syncthreads();
        if (c + 1 < NCH) SSD_LOAD(t0 + TC);
        { const float cL = cum[63];
#pragma unroll
          for (int i = 0; i < 4; ++i) { const int idx = tid + 512 * i, p = idx & 63, t = (idx >> 6) * 2;
              ((LAS unsigned*)VT)[p * 36 + (t >> 1)] = pk2(Xs[t * 64 + p] * Dt[t], Xs[(t + 1) * 64 + p] * Dt[t + 1]); }
#pragma unroll
          for (int i = 0; i < 8; ++i) { const int idx = tid + 512 * i, n = idx & 127, t = (idx >> 7) * 2;
              ((LAS unsigned*)KdT)[n * 36 + (t >> 1)] = pk2(bf2f(Ks[t * 136 + n]) * __expf(cL - cum[t]), bf2f(Ks[(t + 1) * 136 + n]) * __expf(cL - cum[t + 1])); } }
        __syncthreads();
        sd_chunk_core<128>(Qs, Ks, ST, KdT, VT, Gs, Yl, cum, Sacc, wave, lane);
#pragma unroll
        for (int i = 0; i < 8; ++i) { const int t = wave + 8 * i;
            const float y = Yl[t * 64 + lane] + Xs[t * 64 + lane] * dsk;
            bs16(ry, f2bf(y * siluf_(bf2f(Zs[t * 64 + lane]))), voY, yb2 + (t0 + 8 * i) * D * 2); }
        __syncthreads();
    }
#undef SSD_LOAD
}

__device__ __forceinline__ void retm_job(const bf16_t* P, bf16_t* Y, int l, int b, int h, LAS float* lds, int wave_s) {
    const int tid = wave_s * 64 + lv(lane_id());
    const int* positions = (const int*)argf(2);
    const int wave = tid >> 6, lane = tid & 63;
    LAS unsigned char* L = (LAS unsigned char*)lds;
    LAS bf16_t* Qs = (LAS bf16_t*)(L); LAS bf16_t* Ks = (LAS bf16_t*)(L + 9216); LAS bf16_t* ST = (LAS bf16_t*)(L + 18432); LAS bf16_t* KdT = (LAS bf16_t*)(L + 27648);
    LAS bf16_t* VT = (LAS bf16_t*)(L + 36864); LAS bf16_t* Gs = (LAS bf16_t*)(L + 46080); LAS float* Yl = (LAS float*)(L + 55296); LAS float* cum = (LAS float*)(L + 71680);
    const float lg = log1pf(-exp2f(-5.f - (float)h));
    const int ri = tid & 31;
    const double inv_freq = (double)exp2f(-(float)ri * 0.41524101186092033f);
    const float nw = argf(12)[l * 256 + h * 64 + lane];
    f32x4 Sacc[2];
    Sacc[0] = (f32x4){0.f, 0.f, 0.f, 0.f}; Sacc[1] = (f32x4){0.f, 0.f, 0.f, 0.f};
    for (int i = tid; i < 64 * 72 / 2; i += 512) ((LAS unsigned*)ST)[i] = 0u;
    if (tid < 64) cum[tid] = (float)(tid + 1) * lg;
    unsigned q1n[4], q2n[4], k1n[4], k2n[4], vn[8], gn[8], gc[8]; int posn[4];
    const rsrc_t rs = mk_rsrc(P);
    const int rb2 = b * SEQ * INP * 2;
    const rsrc_t ry = mk_rsrc(Y); const int yb2 = b * SEQ * D * 2, voY = (wave * D + 256 + h * 64 + lane) * 2;
    const int voR = ((tid >> 5) * INP + h * 64 + ri) * 2, voV = (wave * INP + h * 64 + lane) * 2, voV2 = (2 * wave * INP + h * 64 + lane) * 2;
#define RET_LOAD(t0_) do { const int t0__ = (t0_); const int so__ = rb2 + t0__ * INP * 2; \
        _Pragma("unroll") for (int i = 0; i < 4; ++i) { const int s2 = so__ + 16 * i * INP * 2; \
            posn[i] = positions[b * SEQ + t0__ + (tid >> 5) + 16 * i]; q1n[i] = bl16(rs, voR, s2 + C_RET_Q * 2); q2n[i] = bl16(rs, voR, s2 + (C_RET_Q + 32) * 2); \
            k1n[i] = bl16(rs, voR, s2 + C_RET_K * 2); k2n[i] = bl16(rs, voR, s2 + (C_RET_K + 32) * 2); } \
        _Pragma("unroll") for (int i = 0; i < 8; ++i) { vn[i] = bl16(rs, voV2, so__ + ((16 * (i >> 1) + (i & 1)) * INP + C_RET_V) * 2); gn[i] = bl16(rs, voV, so__ + (8 * i * INP + C_RET_G) * 2); } } while (0)
    RET_LOAD(0);
    for (int c = 0; c < NCH; ++c) {
        const int t0 = c * TC;
#pragma unroll
        for (int i = 0; i < 4; ++i) { const int t = (tid >> 5) + 16 * i;
            const double ang = (double)posn[i] * inv_freq;
            const double nrev = rint(ang * 0.15915494309189535);
            const float red = (float)fma(-nrev, 6.283185307179586, ang);
            const float cs = cosf(red), sn = sinf(red);
            const float q1 = bfu2f(q1n[i]), q2 = bfu2f(q2n[i]), k1 = bfu2f(k1n[i]) * 0.125f, k2 = bfu2f(k2n[i]) * 0.125f;
            Qs[t * 72 + ri] = f2bf(q1 * cs - q2 * sn); Qs[t * 72 + 32 + ri] = f2bf(q2 * cs + q1 * sn);
            Ks[t * 72 + ri] = f2bf(k1 * cs - k2 * sn); Ks[t * 72 + 32 + ri] = f2bf(k2 * cs + k1 * sn); }
#pragma unroll
        for (int ip = 0; ip < 4; ++ip) { ((LAS unsigned*)VT)[lane * 36 + wave + 8 * ip] = pk2(bfu2f(vn[2 * ip]), bfu2f(vn[2 * ip + 1])); }
#pragma unroll
        for (int i = 0; i < 8; ++i) gc[i] = gn[i];
        __syncthreads();
        if (c + 1 < NCH) RET_LOAD(t0 + TC);
        { const float cL = cum[63];
#pragma unroll
          for (int i = 0; i < 4; ++i) { const int idx = tid + 512 * i, n = idx & 63, t = (idx >> 6) * 2;
              ((LAS unsigned*)KdT)[n * 36 + (t >> 1)] = pk2(bf2f(Ks[t * 72 + n]) * __expf(cL - cum[t]), bf2f(Ks[(t + 1) * 72 + n]) * __expf(cL - cum[t + 1])); } }
        __syncthreads();
        sd_chunk_core<64>(Qs, Ks, ST, KdT, VT, Gs, Yl, cum, Sacc, wave, lane);
#pragma unroll
        for (int i = 0; i < 8; ++i) { const int t = wave + 8 * i; const float y = Yl[t * 64 + lane];
            const float mean = wave_sum(y) * (1.f / 64.f), d = y - mean;
            const float var = wave_sum(d * d) * (1.f / 64.f);
            bs16(ry, f2bf(d * rsqrtf(var + EPS) * nw * siluf_(bfu2f(gc[i]))), voY, yb2 + (t0 + 8 * i) * D * 2); }
        __syncthreads();
    }
#undef RET_LOAD
}

#define XB_TMO      128
#define XB_XCNT(j)  (256  + 64 * (j))
#define XB_XSUB(j)  (1280 + 64 * (j))
#define XB_XGEN(j)  (2304 + 64 * (j))
#define XB_TOP      3328
#define XB_TOPGEN   3392
#define XCD_BAR_WORDS 3456
#define XB_SPIN_CAP (1u << 22)
__device__ __forceinline__ unsigned xb_ld(unsigned* p)              { return __hip_atomic_load(p, __ATOMIC_RELAXED, __HIP_MEMORY_SCOPE_AGENT); }
__device__ __forceinline__ unsigned xb_add(unsigned* p, unsigned v) { return __hip_atomic_fetch_add(p, v, __ATOMIC_RELAXED, __HIP_MEMORY_SCOPE_AGENT); }
__device__ __forceinline__ unsigned xb_xcc_id() { return (unsigned)__builtin_amdgcn_s_getreg((3 << 11) | 20) & 0xFu; }
#define XB_SPIN(cond, bar) do { unsigned _sp = 0; while (cond) { __builtin_amdgcn_s_sleep(1); \
    if ((++_sp & 255u) == 0u) { if (xb_ld(&(bar)[XB_TMO])) break; if (_sp > XB_SPIN_CAP) { atomicAdd(&(bar)[XB_TMO], 1u); break; } } } } while (0)
__device__ __forceinline__ void xcd_barrier_post(unsigned* bar, int wave_s) { if (wave_s == 0 && lane_id() == 0) (void)xb_add(&bar[XB_XCNT(xb_xcc_id())], 1u); }
__device__ __forceinline__ void xcd_barrier_complete(unsigned* bar, unsigned x, unsigned& nloc, unsigned& nx) {
    const unsigned G = gridDim.x * gridDim.y * gridDim.z;
    unsigned sum, cnt, mine, sp = 0u;
    for (;;) {
        sum = 0u; cnt = 0u; mine = 0u;
#pragma unroll
        for (unsigned j = 0; j < 16; ++j) { const unsigned c = xb_ld(&bar[XB_XCNT(j)]); sum += c; cnt += (c > 0u) ? 1u : 0u; mine = (j == x) ? c : mine; }
        if (sum == G) break;
        __builtin_amdgcn_s_sleep(1);
        if ((++sp & 255u) == 0u) { if (xb_ld(&bar[XB_TMO])) break; if (sp > XB_SPIN_CAP) { atomicAdd(&bar[XB_TMO], 1u); break; } }
    }
    nloc = mine > 0u ? mine : 1u; nx = cnt > 0u ? cnt : 1u;
}
__device__ __forceinline__ void xcd_barrier(unsigned* bar, volatile LAS unsigned* st, int wave_s) {
    asm volatile("s_waitcnt vmcnt(0)" ::: "memory");
    __syncthreads();
    if (wave_s == 0 && lane_id() == 0) {
        const unsigned x = xb_xcc_id();
        __builtin_amdgcn_s_waitcnt(0);
        unsigned nloc = st[0], nx = st[1];
        if (nloc == 0u) { xcd_barrier_complete(bar, x, nloc, nx); st[0] = nloc; st[1] = nx; }
        const unsigned old = xb_add(&bar[XB_XSUB(x)], 1u);
        const unsigned gen = old / nloc;
        if (old + 1u == (gen + 1u) * nloc) {
            __builtin_amdgcn_fence(__ATOMIC_RELEASE, "agent");
            asm volatile("s_waitcnt vmcnt(0)" ::: "memory");
            const unsigned og = xb_add(&bar[XB_TOP], 1u);
            const unsigned tg = og / nx;
            if (og + 1u == (tg + 1u) * nx) xb_add(&bar[XB_TOPGEN], 1u);
            else XB_SPIN(xb_ld(&bar[XB_TOPGEN]) == tg, bar);
            __builtin_amdgcn_fence(__ATOMIC_ACQUIRE, "agent");
            xb_add(&bar[XB_XGEN(x)], 1u);
            asm volatile("s_waitcnt vmcnt(0)" ::: "memory");
        } else {
            XB_SPIN(xb_ld(&bar[XB_XGEN(x)]) == gen, bar);
            __builtin_amdgcn_fence(__ATOMIC_ACQUIRE, "agent");
            asm volatile("s_waitcnt vmcnt(0)" ::: "memory");
        }
    }
    __syncthreads();
}
#define GRID_BAR() xcd_barrier((unsigned*)(argws() + WS_BAR), (volatile LAS unsigned*)(lds + LDS_XB), wave_s)

struct Args {
    const float* in[30];
    float* out; unsigned char* ws;
};
#define PH_IDS const int lane = lv(lane_id()), wave = wave_s, tid = wave * 64 + lane, bid = ls(blockIdx.x), G = ls(gridDim.x); (void)lane; (void)wave; unsigned char* ws = argws(); (void)ws;

__device__ __forceinline__ void layer_phases(const int l, LAS unsigned char* lds, const int wave_s) {
    LAS float* ldsf = (LAS float*)lds;
    { PH_IDS
      pg8::StaticOrder S; pg8::Gemm g{(const bf16_t*)(ws + WS_H), (const bf16_t*)(ws + WS_WIN) + (size_t)l * INP * D, T, INP, D}; S.init(T, INP, G, bid);
      pg8::EpiP E{(bf16_t*)(ws + WS_P), INP}; pg8::gemm_phase(lds, g, S, E, wave_s); }
    GRID_BAR();
    { PH_IDS
      const bf16_t* Pj = (const bf16_t*)(ws + WS_P); bf16_t* Y = (bf16_t*)(ws + WS_H);
      for (int job = bid; job < 256; job += G) {
          const int i = job & 127, b = i >> 2, h = i & 3;
          if (job < 128) { ssdm_job(Pj, Y, l, b, h, ldsf, wave_s); gla_job(Pj, Y, l, b, h, ldsf, wave_s); }
          else { retm_job(Pj, Y, l, b, h, ldsf, wave_s); lru_job(Pj, Y, l, b, h, ldsf, wave_s); }
      } }
    GRID_BAR();
    { PH_IDS
      ssd_norm_phase((bf16_t*)(ws + WS_H), argf(11) + l * 256, bid * 8 + wave, G * 8, lane); }
    GRID_BAR();
    { PH_IDS
      float* X = (float*)(ws + WS_X); const float* modl = (const float*)(ws + WS_MOD) + (size_t)l * NB * 6144;
      pg8::StaticOrder S; pg8::Gemm g{(const bf16_t*)(ws + WS_H), (const bf16_t*)(ws + WS_WOUT) + (size_t)l * D * D, T, D, D}; S.init(T, D, G, bid);
      const float* st = l == 0 ? (const float*)nullptr : (const float*)(ws + WS_STATS);
      pg8::EpiRes E{l == 0 ? argf(0) : (const float*)X, X, modl + 2048, st, argf(28), argf(29)}; pg8::gemm_phase(lds, g, S, E, wave_s); }
    GRID_BAR();
    { PH_IDS
      float* X = (float*)(ws + WS_X); const float* modl = (const float*)(ws + WS_MOD) + (size_t)l * NB * 6144;
      ln_phase(X, (float*)nullptr, (bf16_t*)(ws + WS_H), (float*)(ws + WS_STATS), argf(24) + l * D, argf(25) + l * D, modl + 3072, modl + 4096, bid * 8 + wave, G * 8, lane); }
    GRID_BAR();
    { PH_IDS
      pg8::StaticOrder S; pg8::Gemm g{(const bf16_t*)(ws + WS_H), (const bf16_t*)(ws + WS_WUP) + (size_t)l * NUP * D, T, NUP, D}; S.init(T, NUP, G, bid);
      pg8::EpiSwiglu E{(bf16_t*)(ws + WS_P)}; pg8::gemm_phase(lds, g, S, E, wave_s); }
    GRID_BAR();
    { PH_IDS
      float* X = (float*)(ws + WS_X); const float* modl = (const float*)(ws + WS_MOD) + (size_t)l * NB * 6144;
      pg8::StaticOrder S; pg8::Gemm g{(const bf16_t*)(ws + WS_P), (const bf16_t*)(ws + WS_WDN) + (size_t)l * D * DFF, T, D, DFF}; S.init(T, D, G, bid);
      pg8::EpiRes E{X, X, modl + 5120, (const float*)(ws + WS_STATS), argf(24) + l * D, argf(25) + l * D}; pg8::gemm_phase(lds, g, S, E, wave_s); }
    GRID_BAR();
    { PH_IDS
      float* X = (float*)(ws + WS_X); const float* mod1 = (const float*)(ws + WS_MOD) + (size_t)NB * 6144;
      if (l == 0) ln_phase(X, (float*)nullptr, (bf16_t*)(ws + WS_H), (float*)(ws + WS_STATS), argf(28), argf(29), mod1, mod1 + 1024, bid * 8 + wave, G * 8, lane);
      else ln_phase(X, argout(), (bf16_t*)nullptr, (float*)nullptr, argf(28) + D, argf(29) + D, nullptr, nullptr, bid * 8 + wave, G * 8, lane); }
}

__global__ void __launch_bounds__(512, 2) fwd_megakernel(Args a_unused) {
    extern __shared__ __attribute__((aligned(16))) unsigned char lds_raw[];
    LAS unsigned char* lds = (LAS unsigned char*)lds_raw;
    LAS float* ldsf = (LAS float*)lds;
    cg::grid_group grid = cg::this_grid();
    const int wave_s = __builtin_amdgcn_readfirstlane((int)(threadIdx.x >> 6));
    if (threadIdx.x < 4) ((volatile LAS unsigned*)(lds + LDS_XB))[threadIdx.x] = 0u;
    __syncthreads();
    xcd_barrier_post((unsigned*)(argws() + WS_BAR), wave_s);
    { PH_IDS
      constexpr int I_IN = (INP / 64) * (D / 64), I_OUT = (D / 64) * (D / 64), I_UP = (NUP / 64) * (D / 64), I_DN = (D / 64) * (DFF / 64), I_L = I_IN + I_OUT + I_UP + I_DN;
      for (int it = bid; it < 2 * I_L; it += G) {
          const int l = it / I_L; int r = it % I_L;
          if (r < I_IN) { transpose_tile(argf(5) + (size_t)l * D * INW, INW, (bf16_t*)(ws + WS_WIN) + (size_t)l * INP * D, D, (r / 16) * 64, (r % 16) * 64, 0, ldsf, tid); continue; } r -= I_IN;
          if (r < I_OUT) { transpose_tile(argf(23) + (size_t)l * D * D, D, (bf16_t*)(ws + WS_WOUT) + (size_t)l * D * D, D, (r / 16) * 64, (r % 16) * 64, 1, ldsf, tid); continue; } r -= I_OUT;
          if (r < I_UP) { transpose_tile(argf(26) + (size_t)l * D * NUP, NUP, (bf16_t*)(ws + WS_WUP) + (size_t)l * NUP * D, D, (r / 16) * 64, (r % 16) * 64, 2, ldsf, tid); continue; } r -= I_UP;
          transpose_tile(argf(27) + (size_t)l * DFF * D, D, (bf16_t*)(ws + WS_WDN) + (size_t)l * D * DFF, DFF, (r / 44) * 64, (r % 44) * 64, 1, ldsf, tid);
      }
      for (int u = bid; u < 192; u += G) ada_unit(argf(1), argf(3), argf(4), (float*)(ws + WS_MOD), u, ldsf, tid); }
    grid.sync();
    { PH_IDS
      const float* mod = (const float*)(ws + WS_MOD);
      modulate_phase(argf(0), mod + 0, mod + 1024, (bf16_t*)(ws + WS_H), bid * 512 + tid, G * 512); }
    GRID_BAR();
    layer_phases(0, lds, wave_s);
    GRID_BAR();
    layer_phases(1, lds, wave_s);
}

extern "C" void kernel_launch(void* const* d_in, const int* in_sizes, int n_in, void* d_out, int out_size, void* d_ws, size_t ws_size, hipStream_t stream) {
    static int grid_blocks = 0;
    if (grid_blocks == 0) {
        if (n_in != 30 || ws_size < WS_TOTAL) { fprintf(stderr, "kernel_launch: unexpected n_in %d / ws_size %zu (need %zu)\n", n_in, ws_size, (size_t)WS_TOTAL); grid_blocks = -1; return; }
        int dev = 0, cus = 0, per_cu = 0;
        (void)hipGetDevice(&dev);
        (void)hipDeviceGetAttribute(&cus, hipDeviceAttributeMultiprocessorCount, dev);
        if (hipFuncSetAttribute((const void*)fwd_megakernel, hipFuncAttributeMaxDynamicSharedMemorySize, LDS_BYTES) != hipSuccess) fprintf(stderr, "kernel_launch: hipFuncSetAttribute failed\n");
        if (hipOccupancyMaxActiveBlocksPerMultiprocessor(&per_cu, (const void*)fwd_megakernel, 512, LDS_BYTES) != hipSuccess || per_cu < 1) { fprintf(stderr, "kernel_launch: occupancy query gave %d\n", per_cu); per_cu = 1; }
        (void)hipGetLastError();
        grid_blocks = cus * per_cu;
    }
    if (grid_blocks < 0) return;
    if (hipMemsetAsync((char*)d_ws + WS_BAR, 0, 16384, stream) != hipSuccess) { fprintf(stderr, "kernel_launch: memset failed\n"); return; }
    Args a{};
    for (int i = 0; i < 30; ++i) a.in[i] = (const float*)d_in[i];
    a.out = (float*)d_out; a.ws = (unsigned char*)d_ws;
    void* args[] = {&a};
    hipError_t e = hipLaunchCooperativeKernel((const void*)fwd_megakernel, dim3(grid_blocks), dim3(512), args, LDS_BYTES, stream);
    if (e != hipSuccess) fprintf(stderr, "cooperative launch failed: %s (grid %d)\n", hipGetErrorString(e), grid_blocks);
}
```
